# Optimizing an MI355X kernel written in HIP

```python
import jax, jax.numpy as jnp
from jax import lax
import numpy as np

D_MODEL = 1024
BATCH = 8
SEQ = 2048
DEPTH = 2
DEC_BATCH = 128
DEC_SEQ = 8
PAST_LEN = 2048
PAGE_SIZE = 128

CONV_DIM = D_MODEL // 2
CONV_WIDTH = 31
SB_HEADS = 8
SB_HEAD_DIM = 64
SB_DIM = SB_HEADS * SB_HEAD_DIM
SB_BIAS_INIT = -6.0
Q_BLOCK = 128
SC_DIM = D_MODEL // 2
SC_WIDTH = 3
POOL_DIM = D_MODEL // 2
POOL_WINDOWS = (2, 4, 8, 16)
POOL_GROUP = POOL_DIM // len(POOL_WINDOWS)
POOL_MAX = max(POOL_WINDOWS)
FFN_DIM = ((-(-8 * D_MODEL // 3) + 255) // 256) * 256
N_EVEN = (DEPTH + 1) // 2
N_ODD = DEPTH // 2
EPS = 1e-6

kernel_name = "hybrid_conformer_stickbreak_shortconv_pool_decode_step"


def rms_norm(x, g):
    xf = x.astype(jnp.float32)
    y = xf * lax.rsqrt(jnp.mean(xf * xf, axis=-1, keepdims=True) + EPS)
    return (y * g.astype(jnp.float32)).astype(x.dtype)


def layer_norm(x, g, b):
    xf = x.astype(jnp.float32)
    mu = jnp.mean(xf, axis=-1, keepdims=True)
    var = jnp.mean(jnp.square(xf - mu), axis=-1, keepdims=True)
    y = (xf - mu) * lax.rsqrt(var + EPS) * g.astype(jnp.float32) + b.astype(jnp.float32)
    return y.astype(x.dtype)


def causal_depthwise_conv(ext, w):
    c = ext.shape[-1]
    return lax.conv_general_dilated(ext, w[:, None, :].astype(ext.dtype), window_strides=(1,), padding='VALID',
                                    dimension_numbers=('NWC', 'WIO', 'NWC'), feature_group_count=c)


def stick_breaking_attention(q, k, v, bias, q_pos, k_pos):
    n, lq, h, dh = q.shape
    qb = min(Q_BLOCK, lq)
    nb = lq // qb
    scale = dh ** -0.5
    qs = q.reshape(n, nb, qb, h, dh).transpose(1, 0, 2, 3, 4)
    ps = q_pos.reshape(nb, qb)
    bias_f = bias.astype(jnp.float32)[None, :, None, None]

    def block(args):
        qblk, pblk = args
        z = jnp.einsum('nqhd,nkhd->nhqk', qblk, k, preferred_element_type=jnp.float32) * scale + bias_f
        mask = k_pos[None, :] < pblk[:, None]
        log_1m = jnp.where(mask, jax.nn.log_sigmoid(-z), 0.0)
        after = lax.cumsum(log_1m, axis=3, reverse=True) - log_1m
        logw = jnp.where(mask, jax.nn.log_sigmoid(z) + after, -jnp.inf)
        wgt = jnp.exp(logw)
        return jnp.einsum('nhqk,nkhd->nqhd', wgt.astype(v.dtype), v)

    out = lax.map(block, (qs, ps))
    return out.transpose(1, 0, 2, 3, 4).reshape(n, lq, h * dh)


def conformer_sb_mixer(hn, conv_prev, k_past, v_past, start, w_in, conv_w, conv_b, ln_g, ln_b, sb_bias, w_out):
    n, L, _ = hn.shape
    proj = hn @ w_in
    a_val, a_gate, q, k, v = jnp.split(
        proj, [CONV_DIM, 2 * CONV_DIM, 2 * CONV_DIM + SB_DIM, 2 * CONV_DIM + 2 * SB_DIM], axis=-1)
    glu = a_val * jax.nn.sigmoid(a_gate)
    ext = jnp.concatenate([conv_prev, glu], axis=1)
    a = causal_depthwise_conv(ext, conv_w) + conv_b
    a = jax.nn.silu(layer_norm(a, ln_g, ln_b))
    new_conv = ext[:, -(CONV_WIDTH - 1):]
    q = q.reshape(n, L, SB_HEADS, SB_HEAD_DIM)
    k = k.reshape(n, L, SB_HEADS, SB_HEAD_DIM)
    v = v.reshape(n, L, SB_HEADS, SB_HEAD_DIM)
    k_all = jnp.concatenate([k_past, k], axis=1)
    v_all = jnp.concatenate([v_past, v], axis=1)
    q_pos = start + jnp.arange(L, dtype=jnp.int32)
    k_pos = jnp.arange(k_all.shape[1], dtype=jnp.int32)
    b = stick_breaking_attention(q, k_all, v_all, sb_bias, q_pos, k_pos)
    out = jnp.concatenate([a, b], axis=-1) @ w_out
    return out, new_conv, k, v


def shortconv_pool_mixer(hn, sc_prev, pool_prev, start, w_in, sc_w, pool_w, pool_scale, w_out):
    n, L, _ = hn.shape
    proj = hn @ w_in
    gb, gc, xv, u = jnp.split(proj, [SC_DIM, 2 * SC_DIM, 3 * SC_DIM], axis=-1)
    ext = jnp.concatenate([sc_prev, gc * xv], axis=1)
    c = gb * causal_depthwise_conv(ext, sc_w)
    new_sc = ext[:, -(SC_WIDTH - 1):]
    p = POOL_MAX - 1
    pext = jnp.concatenate([pool_prev, u], axis=1)
    cs = jnp.pad(jnp.cumsum(pext.astype(jnp.float32), axis=1), ((0, 0), (1, 0), (0, 0)))
    pos = start + jnp.arange(L, dtype=jnp.int32)
    groups = []
    for gi, w in enumerate(POOL_WINDOWS):
        lo, hi = gi * POOL_GROUP, (gi + 1) * POOL_GROUP
        wsum = cs[:, p + 1:p + 1 + L, lo:hi] - cs[:, p + 1 - w:p + 1 - w + L, lo:hi]
        cnt = jnp.minimum(w, pos + 1).astype(jnp.float32)[None, :, None]
        groups.append(wsum / cnt)
    pooled = jnp.concatenate(groups, axis=-1).astype(u.dtype) - u
    pooled = pooled.reshape(n, L, len(POOL_WINDOWS), POOL_GROUP)
    d = jnp.einsum('nlgc,gcd->nlgd', pooled, pool_w).reshape(n, L, POOL_DIM) * pool_scale
    new_pool = pext[:, -p:]
    out = jnp.concatenate([c, d], axis=-1) @ w_out
    return out, new_sc, new_pool


def swiglu(h, w_in, w_out):
    g, u = jnp.split(h @ w_in, 2, axis=-1)
    return (jax.nn.silu(g) * u) @ w_out


def setup_inputs(seed: int = 0) -> dict:
    key = jax.random.key(seed)
    ks = jax.random.split(key, 32)
    n_pages = PAST_LEN // PAGE_SIZE
    n_pool = (5 * DEC_BATCH * n_pages + 3) // 4
    f32 = jnp.float32
    nrm = lambda k, shape, s: (jax.random.normal(k, shape, f32) * s).astype(f32)
    perm = jax.random.permutation(ks[7], n_pool)
    page_table = perm[:DEC_BATCH * n_pages].reshape(DEC_BATCH, n_pages).astype(jnp.int32)
    e_in = 2 * CONV_DIM + 3 * SB_DIM
    o_in = 3 * SC_DIM + POOL_DIM
    return {
        "x_prompt": nrm(ks[0], (BATCH, SEQ, D_MODEL), 1.0),
        "x_sample": nrm(ks[1], (DEC_BATCH, DEC_SEQ, D_MODEL), 1.0),
        "cache_k": nrm(ks[2], (N_EVEN, n_pool, PAGE_SIZE, SB_HEADS, SB_HEAD_DIM), 1.0),
        "cache_v": nrm(ks[3], (N_EVEN, n_pool, PAGE_SIZE, SB_HEADS, SB_HEAD_DIM), 1.0),
        "state_conformer": nrm(ks[4], (N_EVEN, DEC_BATCH, CONV_WIDTH - 1, CONV_DIM), 0.5),
        "state_shortconv": nrm(ks[5], (N_ODD, DEC_BATCH, SC_WIDTH - 1, SC_DIM), 1.0),
        "state_pool": nrm(ks[6], (N_ODD, DEC_BATCH, POOL_MAX - 1, POOL_DIM), 1.0),
        "page_table": page_table,
        "norm_mix_g": 1.0 + nrm(ks[8], (DEPTH, D_MODEL), 0.02),
        "norm_ffn_g": 1.0 + nrm(ks[9], (DEPTH, D_MODEL), 0.02),
        "norm_final_g": 1.0 + nrm(ks[10], (D_MODEL,), 0.02),
        "w_in_even": nrm(ks[11], (N_EVEN, D_MODEL, e_in), D_MODEL ** -0.5),
        "conv_a_w": nrm(ks[12], (N_EVEN, CONV_WIDTH, CONV_DIM), CONV_WIDTH ** -0.5),
        "conv_a_b": nrm(ks[13], (N_EVEN, CONV_DIM), 0.01),
        "ln_a_g": 1.0 + nrm(ks[14], (N_EVEN, CONV_DIM), 0.02),
        "ln_a_b": nrm(ks[15], (N_EVEN, CONV_DIM), 0.01),
        "sb_bias": SB_BIAS_INIT + nrm(ks[24], (N_EVEN, SB_HEADS), 0.5),
        "w_out_even": nrm(ks[16], (N_EVEN, CONV_DIM + SB_DIM, D_MODEL), (CONV_DIM + SB_DIM) ** -0.5),
        "w_in_odd": nrm(ks[17], (N_ODD, D_MODEL, o_in), D_MODEL ** -0.5),
        "conv_c_w": nrm(ks[18], (N_ODD, SC_WIDTH, SC_DIM), SC_WIDTH ** -0.5),
        "pool_w": nrm(ks[19], (N_ODD, len(POOL_WINDOWS), POOL_GROUP, POOL_GROUP), POOL_GROUP ** -0.5),
        "pool_scale": 1.0 + nrm(ks[20], (N_ODD, POOL_DIM), 0.1),
        "w_out_odd": nrm(ks[21], (N_ODD, SC_DIM + POOL_DIM, D_MODEL), (SC_DIM + POOL_DIM) ** -0.5),
        "w_ffn_in": nrm(ks[22], (DEPTH, D_MODEL, 2 * FFN_DIM), D_MODEL ** -0.5),
        "w_ffn_out": nrm(ks[23], (DEPTH, FFN_DIM, D_MODEL), FFN_DIM ** -0.5),
    }


def reference(x_prompt, x_sample, cache_k, cache_v, state_conformer, state_shortconv, state_pool, page_table,
              norm_mix_g, norm_ffn_g, norm_final_g, w_in_even, conv_a_w, conv_a_b, ln_a_g, ln_a_b, sb_bias,
              w_out_even, w_in_odd, conv_c_w, pool_w, pool_scale, w_out_odd, w_ffn_in, w_ffn_out):

    def trunk(x, start, conv_prev, k_past, v_past, sc_prev, pool_prev):
        h = x
        new_conv, new_k, new_v, new_sc, new_pool = [], [], [], [], []
        for layer in range(DEPTH):
            i = layer // 2
            hn = rms_norm(h, norm_mix_g[layer])
            if layer % 2 == 0:
                mix, c_new, k_new, v_new = conformer_sb_mixer(
                    hn, conv_prev(i), k_past(i), v_past(i), start, w_in_even[i], conv_a_w[i], conv_a_b[i],
                    ln_a_g[i], ln_a_b[i], sb_bias[i], w_out_even[i])
                new_conv.append(c_new)
                new_k.append(k_new)
                new_v.append(v_new)
            else:
                mix, s_new, p_new = shortconv_pool_mixer(
                    hn, sc_prev(i), pool_prev(i), start, w_in_odd[i], conv_c_w[i], pool_w[i], pool_scale[i],
                    w_out_odd[i])
                new_sc.append(s_new)
                new_pool.append(p_new)
            h = h + mix
            h = h + swiglu(rms_norm(h, norm_ffn_g[layer]), w_ffn_in[layer], w_ffn_out[layer])
        y = rms_norm(h, norm_final_g)
        return (y, jnp.stack(new_k), jnp.stack(new_v), jnp.stack(new_conv), jnp.stack(new_sc), jnp.stack(new_pool))

    bp, dt = x_prompt.shape[0], x_prompt.dtype
    y_p, k_p, v_p, conv_p, sc_p, pool_p = trunk(
        x_prompt, 0,
        lambda i: jnp.zeros((bp, CONV_WIDTH - 1, CONV_DIM), dt),
        lambda i: jnp.zeros((bp, 0, SB_HEADS, SB_HEAD_DIM), dt),
        lambda i: jnp.zeros((bp, 0, SB_HEADS, SB_HEAD_DIM), dt),
        lambda i: jnp.zeros((bp, SC_WIDTH - 1, SC_DIM), dt),
        lambda i: jnp.zeros((bp, POOL_MAX - 1, POOL_DIM), dt))

    bs = x_sample.shape[0]
    past_len = page_table.shape[1] * cache_k.shape[2]
    gather = lambda cache, i: cache[i][page_table].reshape(bs, past_len, SB_HEADS, SB_HEAD_DIM)
    y_s, k_s, v_s, conv_s, sc_s, pool_s = trunk(
        x_sample, past_len,
        lambda i: state_conformer[i],
        lambda i: gather(cache_k, i),
        lambda i: gather(cache_v, i),
        lambda i: state_shortconv[i],
        lambda i: state_pool[i])

    return (y_p, y_s, k_p, v_p, k_s, v_s, conv_p, conv_s, sc_p, sc_s, pool_p, pool_s)
```

```cpp
#include <hip/hip_runtime.h>
#include <cstdio>
#include <cstdint>

namespace pg8 {
#define PG8_LAS __attribute__((address_space(3)))
typedef unsigned short bf16_t;
typedef short bf16x8 __attribute__((ext_vector_type(8)));
typedef float f32x4 __attribute__((ext_vector_type(4)));
typedef unsigned u32x4 __attribute__((ext_vector_type(4)));
constexpr int BM = 256, BK = 64, HALF = 128, HTB = HALF * BK * 2  , STAGE_BYTES = 8 * HTB, NXCD = 8, WGM = 8;

__host__ __device__ __forceinline__ int lds_byte(int r, int c) { const int st = (r >> 4) * 2 + (c >> 5), rr = r & 15, cc = c & 31, ob = rr * 64 + cc * 2; return st * 1024 + (ob ^ (((ob >> 9) & 1) << 5)); }
__host__ __device__ __forceinline__ void stage_rc(int b, int& R, int& C) { const int st = b / 1024, sb = b % 1024, swz = sb ^ (((sb >> 9) & 1) << 5); R = (st >> 1) * 16 + swz / 64; C = (st & 1) * 32 + (swz % 64) / 2; }
__host__ __device__ __forceinline__ int perm32(int rho) { const int n = rho >> 4, i = rho & 15; return 8 * (i >> 2) + 4 * n + (i & 3); }

struct Unit { int pm, pn, i; };
struct Gemm { const bf16_t* A; const bf16_t* Bt; int M, N, K; };

struct StaticOrder {
    int nM, nN, nwg, G, c;
    __host__ __device__ void init(int M, int N, int G_, int c_) { nM = M / BM; nN = N / BM; nwg = nM * nN; G = G_; c = c_; }
    __host__ __device__ bool next(int i, Unit& u) const {
        const long L = (long)i * G + c; if (L >= nwg) return false;
        int wgid = (int)L; { const int q = nwg / NXCD, r = nwg % NXCD, xcd = wgid % NXCD, off = wgid / NXCD; wgid = (xcd < r ? xcd * (q + 1) : r * (q + 1) + (xcd - r) * q) + off; }
        const int nig = WGM * nN, gid = wgid / nig, fm = gid * WGM, gsz = (nM - fm) < WGM ? (nM - fm) : WGM;
        u.pm = fm + ((wgid % nig) % gsz); u.pn = (wgid % nig) / gsz; u.i = i; return true;
    }
    __device__ __forceinline__ void a_ready(const Unit&) const {}
    __device__ __forceinline__ void done(const Unit&) const {}
};

__device__ __forceinline__ unsigned cvt_pk_bf16(float lo, float hi) { unsigned r; asm volatile("v_cvt_pk_bf16_f32 %0, %1, %2" : "=v"(r) : "v"(lo), "v"(hi)); return r; }
typedef float f32x2 __attribute__((ext_vector_type(2)));
typedef unsigned u32x4e __attribute__((ext_vector_type(4)));
constexpr int NROWS_P = 16384;
constexpr float RMS_EPS = 1e-6f;
constexpr size_t XMiB = 1u << 20, XWS_STATS = 50 * XMiB, XWS_XN = 52 * XMiB, XWS_GLU = 86 * XMiB, XWS_Q = 103 * XMiB, XWS_K = 120 * XMiB, XWS_V = 137 * XMiB, XWS_AB = 154 * XMiB, XWS_ACT = 188 * XMiB, XWS_LO = 282 * XMiB;
constexpr size_t XO_KP = (size_t)17408 * 1024, XO_VP = XO_KP + (size_t)16384 * 512, XO_KS = XO_VP + (size_t)16384 * 512, XO_VS = XO_KS + (size_t)1024 * 512;
constexpr float XQSCALE = 0.125f * 1.4426950408889634f;
constexpr int RS_OFF = 131072, RS_SLOTS = 8;
template <class Sched> __device__ __forceinline__ void prefetch_rowscale(PG8_LAS unsigned char* lds, const float* stats, const Sched& S, int tid, int wid) {
    PG8_LAS float* T = (PG8_LAS float*)(lds + RS_OFF);
    const int r = tid & 255, sh = wid >> 2;
    f32x4 v[4][4]; bool ok[4];
#pragma unroll
    for (int j = 0; j < 4; ++j) { Unit u{0, 0, 0}; ok[j] = S.next(2 * j + sh, u); const int pm = ok[j] ? u.pm : 0;
        const f32x4* p = (const f32x4*)(stats + (size_t)(pm * BM + r) * 16);
        v[j][0] = p[0]; v[j][1] = p[1]; v[j][2] = p[2]; v[j][3] = p[3]; }
#pragma unroll
    for (int j = 0; j < 4; ++j) { const f32x4 a = v[j][0], b = v[j][1], c = v[j][2], d = v[j][3];
        const float s = ((a[0] + a[1]) + (a[2] + a[3])) + ((b[0] + b[1]) + (b[2] + b[3])) + ((c[0] + c[1]) + (c[2] + c[3])) + ((d[0] + d[1]) + (d[2] + d[3]));
        if (ok[j]) T[(2 * j + sh) * 256 + r] = 1.0f / sqrtf(s * (1.0f / 1024.0f) + RMS_EPS); }
    __syncthreads();
}
__device__ __forceinline__ void load_rowscale(float (&rs)[2][4], PG8_LAS const unsigned char* lds, const Unit& u, int wr, int fr) {
    const PG8_LAS float* T = (const PG8_LAS float*)(lds + RS_OFF) + (u.i & (RS_SLOTS - 1)) * 256;
#pragma unroll
    for (int ai = 0; ai < 2; ++ai)
#pragma unroll
        for (int m = 0; m < 4; ++m) rs[ai][m] = T[ai * HALF + wr * 64 + m * 16 + fr];
}
__device__ __forceinline__ float sigmoidf_(float x) { return __builtin_amdgcn_rcpf(1.0f + __builtin_amdgcn_exp2f(-1.4426950408889634f * x)); }
__device__ __forceinline__ f32x4 sigmoid4(const f32x4 x) { const f32x4 t = x * -1.4426950408889634f; const f32x4 e = {__builtin_amdgcn_exp2f(t[0]), __builtin_amdgcn_exp2f(t[1]), __builtin_amdgcn_exp2f(t[2]), __builtin_amdgcn_exp2f(t[3])};
    const f32x4 d = e + 1.0f; return (f32x4){__builtin_amdgcn_rcpf(d[0]), __builtin_amdgcn_rcpf(d[1]), __builtin_amdgcn_rcpf(d[2]), __builtin_amdgcn_rcpf(d[3])}; }
__device__ __forceinline__ u32x4e pack8(const f32x4 a, const f32x4 b) { u32x4e w; w.x = cvt_pk_bf16(a[0], a[1]); w.y = cvt_pk_bf16(a[2], a[3]); w.z = cvt_pk_bf16(b[0], b[1]); w.w = cvt_pk_bf16(b[2], b[3]); return w; }

struct EpiInEven {
    static constexpr bool PERM = true, AFTER_DRAIN = false, INIT_ACC = false, ROWSCALE = true;
    unsigned char* ws; float* out; PG8_LAS unsigned char* lds;
    __device__ __forceinline__ void operator()(const f32x4 (&acc)[2][2][4][2], const Unit& u, int wr, int wc, int fr, int fq) const {
        const float* stats = (const float*)(ws + XWS_STATS); bf16_t* GLU = (bf16_t*)(ws + XWS_GLU); bf16_t* Q = (bf16_t*)(ws + XWS_Q); bf16_t* Kb = (bf16_t*)(ws + XWS_K); bf16_t* Vb = (bf16_t*)(ws + XWS_V);
        float* kp = out + XO_KP; float* vp = out + XO_VP; float* ks = out + XO_KS; float* vs = out + XO_VS; const float qscale = XQSCALE;
        float rs[2][4]; load_rowscale(rs, lds, u, wr, fr);
        const int pn = u.pn;
        if (pn < 4) {
#pragma unroll
            for (int ai = 0; ai < 2; ++ai)
#pragma unroll
                for (int m = 0; m < 4; ++m) { const int row = u.pm * BM + ai * HALF + wr * 64 + m * 16 + fr; const float r = rs[ai][m];
                    f32x4 o[2];
#pragma unroll
                    for (int n = 0; n < 2; ++n) { const f32x4 val = acc[ai][0][m][n] * r, gate = acc[ai][1][m][n] * r; o[n] = val * sigmoid4(gate); }
                    *(u32x4e*)(GLU + (size_t)row * 512 + pn * 128 + wc * 32 + 8 * fq) = pack8(o[0], o[1]); }
        } else {
            const int t = (pn - 4) >> 1, colt = ((pn - 4) & 1) * 256;
#pragma unroll
            for (int ai = 0; ai < 2; ++ai)
#pragma unroll
                for (int m = 0; m < 4; ++m) { const int row = u.pm * BM + ai * HALF + wr * 64 + m * 16 + fr; const float r = rs[ai][m];
#pragma unroll
                    for (int bj = 0; bj < 2; ++bj) { const int col = colt + bj * HALF + wc * 32 + 8 * fq;
                        f32x4 v0 = acc[ai][bj][m][0] * r, v1 = acc[ai][bj][m][1] * r;
                        if (t == 0) { v0 = v0 * qscale; v1 = v1 * qscale; *(u32x4e*)(Q + (size_t)row * 512 + col) = pack8(v0, v1); }
                        else { float* fo; bf16_t* bo;
                            if (t == 1) { fo = row < NROWS_P ? kp + (size_t)row * 512 : ks + (size_t)(row - NROWS_P) * 512; bo = Kb; }
                            else        { fo = row < NROWS_P ? vp + (size_t)row * 512 : vs + (size_t)(row - NROWS_P) * 512; bo = Vb; }
                            *(f32x4*)(fo + col) = v0; *(f32x4*)(fo + col + 4) = v1; *(u32x4e*)(bo + (size_t)row * 512 + col) = pack8(v0, v1); } } }
        }
    }
};
struct EpiInOdd {
    static constexpr bool PERM = true, AFTER_DRAIN = false, INIT_ACC = false, ROWSCALE = true;
    unsigned char* ws; PG8_LAS unsigned char* lds;
    __device__ __forceinline__ void operator()(const f32x4 (&acc)[2][2][4][2], const Unit& u, int wr, int wc, int fr, int fq) const {
        const float* stats = (const float*)(ws + XWS_STATS); bf16_t* GB = (bf16_t*)(ws + XWS_GLU); bf16_t* CX = (bf16_t*)(ws + XWS_Q); bf16_t* U = (bf16_t*)(ws + XWS_K);
        float rs[2][4]; load_rowscale(rs, lds, u, wr, fr);
        const int pn = u.pn;
        if (pn >= 2 && pn < 6) {
#pragma unroll
            for (int ai = 0; ai < 2; ++ai)
#pragma unroll
                for (int m = 0; m < 4; ++m) { const int row = u.pm * BM + ai * HALF + wr * 64 + m * 16 + fr; const float r2 = rs[ai][m] * rs[ai][m];
                    const f32x4 o0 = acc[ai][0][m][0] * acc[ai][1][m][0] * r2, o1 = acc[ai][0][m][1] * acc[ai][1][m][1] * r2;
                    *(u32x4e*)(CX + (size_t)row * 512 + (pn - 2) * 128 + wc * 32 + 8 * fq) = pack8(o0, o1); }
        } else {
            bf16_t* O = pn < 2 ? GB : U; const int colt = (pn & 1) * 256;
#pragma unroll
            for (int ai = 0; ai < 2; ++ai)
#pragma unroll
                for (int m = 0; m < 4; ++m) { const int row = u.pm * BM + ai * HALF + wr * 64 + m * 16 + fr; const float r = rs[ai][m];
#pragma unroll
                    for (int bj = 0; bj < 2; ++bj) *(u32x4e*)(O + (size_t)row * 512 + colt + bj * HALF + wc * 32 + 8 * fq) = pack8(acc[ai][bj][m][0] * r, acc[ai][bj][m][1] * r); }
        }
    }
};
struct EpiFfn {
    static constexpr bool PERM = true, AFTER_DRAIN = false, INIT_ACC = false, ROWSCALE = true;
    unsigned char* ws; PG8_LAS unsigned char* lds;
    __device__ __forceinline__ void operator()(const f32x4 (&acc)[2][2][4][2], const Unit& u, int wr, int wc, int fr, int fq) const {
        const float* stats = (const float*)(ws + XWS_STATS); bf16_t* ACT = (bf16_t*)(ws + XWS_ACT);
        float rs[2][4]; load_rowscale(rs, lds, u, wr, fr);
#pragma unroll
        for (int ai = 0; ai < 2; ++ai)
#pragma unroll
            for (int m = 0; m < 4; ++m) { const int row = u.pm * BM + ai * HALF + wr * 64 + m * 16 + fr; const float r = rs[ai][m];
                f32x4 o[2];
#pragma unroll
                for (int n = 0; n < 2; ++n) { const f32x4 g = acc[ai][0][m][n] * r, uu = acc[ai][1][m][n] * r; o[n] = g * sigmoid4(g) * uu; }
                *(u32x4e*)(ACT + (size_t)row * 2816 + u.pn * 128 + wc * 32 + 8 * fq) = pack8(o[0], o[1]); }
    }
};
__device__ __forceinline__ float bf_lo_(unsigned w) { return __builtin_bit_cast(float, w << 16); }
__device__ __forceinline__ float bf_hi_(unsigned w) { return __builtin_bit_cast(float, w & 0xffff0000u); }
__device__ __forceinline__ void split8(const f32x4 x0, const f32x4 x1, u32x4e& hi, u32x4e& lo) {
    hi = pack8(x0, x1);
    const f32x4 r0 = {x0[0] - bf_lo_(hi.x), x0[1] - bf_hi_(hi.x), x0[2] - bf_lo_(hi.y), x0[3] - bf_hi_(hi.y)}, r1 = {x1[0] - bf_lo_(hi.z), x1[1] - bf_hi_(hi.z), x1[2] - bf_lo_(hi.w), x1[3] - bf_hi_(hi.w)};
    lo = pack8(r0, r1);
}
__device__ __forceinline__ void join8(const u32x4e hi, const u32x4e lo, f32x4& x0, f32x4& x1) {
    x0 = (f32x4){bf_lo_(hi.x) + bf_lo_(lo.x), bf_hi_(hi.x) + bf_hi_(lo.x), bf_lo_(hi.y) + bf_lo_(lo.y), bf_hi_(hi.y) + bf_hi_(lo.y)};
    x1 = (f32x4){bf_lo_(hi.z) + bf_lo_(lo.z), bf_hi_(hi.z) + bf_hi_(lo.z), bf_lo_(hi.w) + bf_lo_(lo.w), bf_hi_(hi.w) + bf_hi_(lo.w)};
}
template <bool BASE_F32, bool RLO = true, bool WLO = true> struct EpiRes {
    static constexpr bool PERM = true, AFTER_DRAIN = false, INIT_ACC = true, ROWSCALE = false;
    unsigned char* ws; const float* base_p; const float* base_s;
    __device__ __forceinline__ void init(f32x4 (&acc)[2][2][4][2], const Unit& u, int wr, int wc, int fr, int fq) const {
        const int col0 = u.pn * BM + wc * 32 + 8 * fq;
        const bf16_t* HI = (const bf16_t*)(ws + XWS_XN); const bf16_t* LO = (const bf16_t*)(ws + XWS_LO);
#pragma unroll
        for (int ai = 0; ai < 2; ++ai)
#pragma unroll
            for (int m = 0; m < 4; ++m) { const int row = u.pm * BM + ai * HALF + wr * 64 + m * 16 + fr;
                if constexpr (BASE_F32) { const float* b = row < NROWS_P ? base_p + (size_t)row * 1024 : base_s + (size_t)(row - NROWS_P) * 1024;
#pragma unroll
                    for (int bj = 0; bj < 2; ++bj) { acc[ai][bj][m][0] = __builtin_nontemporal_load((const f32x4*)(b + col0 + bj * HALF)); acc[ai][bj][m][1] = __builtin_nontemporal_load((const f32x4*)(b + col0 + bj * HALF + 4)); }
                } else {
#pragma unroll
                    for (int bj = 0; bj < 2; ++bj) { const size_t o = (size_t)row * 1024 + col0 + bj * HALF;
                        if constexpr (RLO) join8(*(const u32x4e*)(HI + o), *(const u32x4e*)(LO + o), acc[ai][bj][m][0], acc[ai][bj][m][1]);
                        else { const u32x4e hi = *(const u32x4e*)(HI + o); acc[ai][bj][m][0] = (f32x4){bf_lo_(hi.x), bf_hi_(hi.x), bf_lo_(hi.y), bf_hi_(hi.y)}; acc[ai][bj][m][1] = (f32x4){bf_lo_(hi.z), bf_hi_(hi.z), bf_lo_(hi.w), bf_hi_(hi.w)}; } } } }
    }
    __device__ __forceinline__ void operator()(const f32x4 (&acc)[2][2][4][2], const Unit& u, int wr, int wc, int fr, int fq) const {
        bf16_t* HI = (bf16_t*)(ws + XWS_XN); bf16_t* LO = (bf16_t*)(ws + XWS_LO); float* stats = (float*)(ws + XWS_STATS);
        const int col0 = u.pn * BM + wc * 32 + 8 * fq;
#pragma unroll
        for (int ai = 0; ai < 2; ++ai)
#pragma unroll
            for (int m = 0; m < 4; ++m) { const int row = u.pm * BM + ai * HALF + wr * 64 + m * 16 + fr; float ss = 0.f;
#pragma unroll
                for (int bj = 0; bj < 2; ++bj) { const size_t o = (size_t)row * 1024 + col0 + bj * HALF;
                    const f32x4 x0 = acc[ai][bj][m][0], x1 = acc[ai][bj][m][1];
                    ss += (x0[0] * x0[0] + x0[1] * x0[1]) + (x0[2] * x0[2] + x0[3] * x0[3]) + (x1[0] * x1[0] + x1[1] * x1[1]) + (x1[2] * x1[2] + x1[3] * x1[3]);
                    if constexpr (WLO) { u32x4e hi, lo; split8(x0, x1, hi, lo); *(u32x4e*)(HI + o) = hi; *(u32x4e*)(LO + o) = lo; } else *(u32x4e*)(HI + o) = pack8(x0, x1); }
                ss += __shfl_xor(ss, 16); ss += __shfl_xor(ss, 32);
                if (fq == 0) stats[(size_t)row * 16 + 4 * u.pn + wc] = ss; }
    }
};
using EpiRes0 = EpiRes<true, false, false>; using EpiResM = EpiRes<false, false, false>; using EpiResL = EpiRes<false, false, true>;

template <class Epi, class Sched, bool ALIGN_EPI = false, bool SP2 = false>
__device__ __forceinline__ void gemm_phase(PG8_LAS unsigned char* lds, const Gemm g, const Sched& S, const Epi& E, const int wid) {
    int lane_v; asm volatile("v_mbcnt_lo_u32_b32 %0, -1, 0\n\tv_mbcnt_hi_u32_b32 %0, -1, %0" : "=v"(lane_v)); const int lane = lane_v, tid = wid * 64 + lane, wr = wid >> 2, wc = wid & 3, fr = lane & 15, fq = lane >> 4;
    const int K = g.K, nt = K / BK;
    unsigned voffA[2], voffB[2];
#pragma unroll
    for (int i = 0; i < 2; ++i) { int R, C; stage_rc(tid * 16 + i * 8192, R, C); const int Rb = Epi::PERM ? ((R & ~31) + perm32(R & 31)) : R;
        voffA[i] = (unsigned)(R * K + C) * 2u; voffB[i] = (unsigned)(Rb * K + C) * 2u; }
    const size_t kstep = (size_t)(BK * 2);
    const size_t hstep = (size_t)HALF * K * 2;
    const size_t tstep = 2 * hstep;
    const unsigned ldsw = (unsigned)wid * 1024u;
    const int aoff = lds_byte(wr * 64 + fr, fq * 8), boff = lds_byte(wc * 32 + fr, fq * 8);
#define PG8_SA(b, h) (((b) * 2 + (h)) * HTB)
#define PG8_SB(b, h) ((4 + (b) * 2 + (h)) * HTB)
#define PG8_STAGE(bufoff, gbase, voff) do { _Pragma("unroll") for (int _i = 0; _i < 2; ++_i) \
        __builtin_amdgcn_global_load_lds((const unsigned*)((const char*)(gbase) + (voff)[_i]), (PG8_LAS unsigned*)(lds + (bufoff) + ldsw + _i * 8192), 16, 0, 0); } while (0)
#define PG8_LDA(dst, b, h) do { _Pragma("unroll") for (int m = 0; m < 4; ++m) _Pragma("unroll") for (int k = 0; k < 2; ++k) dst[m][k] = *(const PG8_LAS bf16x8*)(lds + PG8_SA(b, h) + aoff + m * 2048 + k * 1024); } while (0)
#define PG8_LDB(dst, b, h) do { _Pragma("unroll") for (int n = 0; n < 2; ++n) _Pragma("unroll") for (int k = 0; k < 2; ++k) dst[n][k] = *(const PG8_LAS bf16x8*)(lds + PG8_SB(b, h) + boff + n * 2048 + k * 1024); } while (0)
#define PG8_MMA(ai, bj, At, Bt) do { __builtin_amdgcn_s_setprio(1); _Pragma("unroll") for (int m = 0; m < 4; ++m) _Pragma("unroll") for (int n = 0; n < 2; ++n) _Pragma("unroll") for (int k = 0; k < 2; ++k) \
        acc[ai][bj][m][n] = __builtin_amdgcn_mfma_f32_16x16x32_bf16(Bt[n][k], At[m][k], acc[ai][bj][m][n], 0, 0, 0); __builtin_amdgcn_s_setprio(0); } while (0)
#define PG8_WAIT_V(n) asm volatile("s_waitcnt vmcnt(" #n ")" ::: "memory")
#define PG8_WAIT_L(n) asm volatile("s_waitcnt lgkmcnt(" #n ")" ::: "memory")
#define PG8_BAR __builtin_amdgcn_s_barrier()
#define PG8_SCHED __builtin_amdgcn_sched_barrier(0)
    Unit cur, nxt; int ui = 0;
    if (!S.next(0, cur)) return;
    f32x4 acc[2][2][4][2];
#pragma unroll
    for (int a = 0; a < 2; ++a)
#pragma unroll
        for (int b = 0; b < 2; ++b)
#pragma unroll
            for (int m = 0; m < 4; ++m)
#pragma unroll
                for (int n = 0; n < 2; ++n) acc[a][b][m][n] = (f32x4){0.f, 0.f, 0.f, 0.f};
    if constexpr (Epi::INIT_ACC) E.init(acc, cur, wr, wc, fr, fq);
    bf16x8 At[4][2], B0[2][2], B1[2][2];
    const char* cA = (const char*)g.A + (size_t)cur.pm * tstep; const char* cB = (const char*)g.Bt + (size_t)cur.pn * tstep;
    S.a_ready(cur);
    if constexpr (SP2) {
        PG8_STAGE(PG8_SB(0, 0), cB, voffB); PG8_STAGE(PG8_SB(0, 1), cB + hstep, voffB); PG8_STAGE(PG8_SA(0, 0), cA, voffA); PG8_STAGE(PG8_SA(0, 1), cA + hstep, voffA);
        if (wr == 1) PG8_BAR;
        PG8_WAIT_V(2); PG8_BAR;
        PG8_STAGE(PG8_SB(1, 0), cB + kstep, voffB); PG8_STAGE(PG8_SA(1, 0), cA + kstep, voffA); PG8_STAGE(PG8_SB(1, 1), cB + hstep + kstep, voffB);
        PG8_WAIT_V(6); PG8_BAR;
    } else {
        PG8_STAGE(PG8_SB(0, 0), cB, voffB); PG8_STAGE(PG8_SA(0, 0), cA, voffA); PG8_STAGE(PG8_SB(0, 1), cB + hstep, voffB); PG8_STAGE(PG8_SA(0, 1), cA + hstep, voffA);
        if (wr == 1) PG8_BAR;
        PG8_WAIT_V(4); PG8_BAR;
        PG8_STAGE(PG8_SB(1, 0), cB + kstep, voffB); PG8_STAGE(PG8_SA(1, 0), cA + kstep, voffA); PG8_STAGE(PG8_SB(1, 1), cB + hstep + kstep, voffB);
        PG8_WAIT_V(6); PG8_BAR;
    }
    for (;;) {
        const bool has_next = S.next(ui + 1, nxt);
        const char* nA = has_next ? (const char*)g.A + (size_t)nxt.pm * tstep : cA; const char* nB = has_next ? (const char*)g.Bt + (size_t)nxt.pn * tstep : cB;
        for (int t = 0; t < nt; t += 2) {
            const bool last = (t == nt - 2);
            const char* a1 = cA + (size_t)(t + 1) * kstep;
            const char* a2 = last ? nA : cA + (size_t)(t + 2) * kstep; const char* b2 = last ? nB : cB + (size_t)(t + 2) * kstep;
            const char* a3 = a2 + kstep; const char* b3 = b2 + kstep;
            if (last && has_next) S.a_ready(nxt);
            if constexpr (SP2) {
            PG8_LDB(B0, 0, 0); PG8_LDB(B1, 0, 1); PG8_SCHED; PG8_LDA(At, 0, 0); PG8_STAGE(PG8_SA(1, 1), a1 + hstep, voffA);
            PG8_WAIT_V(8); PG8_WAIT_L(0); PG8_BAR; PG8_MMA(0, 0, At, B0); PG8_MMA(0, 1, At, B1); PG8_BAR; PG8_SCHED;
            PG8_LDA(At, 0, 1); PG8_STAGE(PG8_SB(0, 0), b2, voffB); PG8_STAGE(PG8_SB(0, 1), b2 + hstep, voffB); PG8_STAGE(PG8_SA(0, 0), a2, voffA);
            PG8_WAIT_V(8); PG8_WAIT_L(0); PG8_BAR; PG8_MMA(1, 0, At, B0); PG8_MMA(1, 1, At, B1); PG8_BAR; PG8_SCHED;
            PG8_LDB(B0, 1, 0); PG8_LDB(B1, 1, 1); PG8_SCHED; PG8_LDA(At, 1, 0); PG8_STAGE(PG8_SA(0, 1), a2 + hstep, voffA);
            PG8_WAIT_V(8); PG8_WAIT_L(0); PG8_BAR; PG8_MMA(0, 0, At, B0); PG8_MMA(0, 1, At, B1); PG8_BAR; PG8_SCHED;
            PG8_LDA(At, 1, 1); PG8_STAGE(PG8_SB(1, 0), b3, voffB); PG8_STAGE(PG8_SB(1, 1), b3 + hstep, voffB); PG8_STAGE(PG8_SA(1, 0), a3, voffA);
            PG8_WAIT_V(8); PG8_WAIT_L(0); PG8_BAR; PG8_MMA(1, 0, At, B0); PG8_MMA(1, 1, At, B1); PG8_BAR; PG8_SCHED;
            } else {
            PG8_LDB(B0, 0, 0); PG8_SCHED; PG8_LDA(At, 0, 0); PG8_STAGE(PG8_SA(1, 1), a1 + hstep, voffA);
            PG8_WAIT_L(8); PG8_BAR; PG8_WAIT_L(0); PG8_MMA(0, 0, At, B0); PG8_BAR; PG8_SCHED;
            PG8_LDB(B1, 0, 1); PG8_STAGE(PG8_SB(0, 0), b2, voffB);
            PG8_BAR; PG8_WAIT_L(0); PG8_MMA(0, 1, At, B1); PG8_BAR;
            PG8_LDA(At, 0, 1); PG8_STAGE(PG8_SA(0, 0), a2, voffA);
            PG8_BAR; PG8_WAIT_L(0); PG8_MMA(1, 0, At, B0); PG8_BAR; PG8_SCHED;
            PG8_STAGE(PG8_SB(0, 1), b2 + hstep, voffB);
            PG8_WAIT_V(6); PG8_BAR; PG8_MMA(1, 1, At, B1); PG8_BAR;
            PG8_LDB(B0, 1, 0); PG8_SCHED; PG8_LDA(At, 1, 0); PG8_STAGE(PG8_SA(0, 1), a2 + hstep, voffA);
            PG8_WAIT_L(8); PG8_BAR; PG8_WAIT_L(0); PG8_MMA(0, 0, At, B0); PG8_BAR; PG8_SCHED;
            PG8_LDB(B1, 1, 1); PG8_STAGE(PG8_SB(1, 0), b3, voffB);
            PG8_BAR; PG8_WAIT_L(0); PG8_MMA(0, 1, At, B1); PG8_BAR;
            PG8_LDA(At, 1, 1); PG8_STAGE(PG8_SA(1, 0), a3, voffA);
            PG8_BAR; PG8_WAIT_L(0); PG8_MMA(1, 0, At, B0); PG8_BAR; PG8_SCHED;
            PG8_STAGE(PG8_SB(1, 1), b3 + hstep, voffB);
            PG8_WAIT_V(6); PG8_BAR; PG8_MMA(1, 1, At, B1); PG8_BAR;
            }
        }
        if constexpr (ALIGN_EPI) { if (wr == 0) PG8_BAR; }
        if constexpr (!Epi::AFTER_DRAIN) { E(acc, cur, wr, wc, fr, fq); S.done(cur); }
        if (!has_next) break;
#pragma unroll
        for (int a = 0; a < 2; ++a)
#pragma unroll
            for (int b = 0; b < 2; ++b)
#pragma unroll
                for (int m = 0; m < 4; ++m)
#pragma unroll
                    for (int n = 0; n < 2; ++n) acc[a][b][m][n] = (f32x4){0.f, 0.f, 0.f, 0.f};
        if constexpr (Epi::INIT_ACC) E.init(acc, nxt, wr, wc, fr, fq);
        cur = nxt; cA = nA; cB = nB; ++ui;
        if constexpr (ALIGN_EPI) { if (wr == 1) PG8_BAR; }
    }
    PG8_WAIT_V(0);
    if constexpr (!ALIGN_EPI) { if (wr == 0) PG8_BAR; }
    PG8_BAR;
    if constexpr (Epi::AFTER_DRAIN) { E.fused(acc, cur, wr, wc, fr, fq, lds, wid, lane); S.done(cur); }
#undef PG8_SA
#undef PG8_SB
#undef PG8_STAGE
#undef PG8_LDA
#undef PG8_LDB
#undef PG8_MMA
#undef PG8_WAIT_V
#undef PG8_WAIT_L
#undef PG8_BAR
#undef PG8_SCHED
}
}
constexpr int NWAVES = 8;
constexpr int DM = 1024, MP = 16384, MS = 1024, MT = MP + MS;
constexpr int SEQ = 2048, DSEQ = 8, NB = 8, NDB = 128, PAST = 2048, PAGE = 128, NPAGES = 16;
constexpr int CD_ = 512, CW = 31, NH = 8, HD = 64, FFN = 2816;
constexpr int N_IN_E = 2560, N_IN_O = 2048, N_FF = 2 * FFN;
constexpr float EPS = 1e-6f;
constexpr float LOG2E = 1.4426950408889634f;
constexpr float QSCALE = 0.125f * LOG2E;

constexpr size_t O_Y = 0, O_KP = (size_t)MT * DM, O_VP = O_KP + (size_t)MP * 512, O_KS = O_VP + (size_t)MP * 512, O_VS = O_KS + (size_t)MS * 512;
constexpr size_t O_CONVP = O_VS + (size_t)MS * 512, O_CONVS = O_CONVP + (size_t)NB * 30 * 512, O_SCP = O_CONVS + (size_t)NDB * 30 * 512, O_SCS = O_SCP + (size_t)NB * 2 * 512;
constexpr size_t O_POOLP = O_SCS + (size_t)NDB * 2 * 512, O_POOLS = O_POOLP + (size_t)NB * 15 * 512, O_END = O_POOLS + (size_t)NDB * 15 * 512;
static_assert(O_END == 38924288, "d_out map");

constexpr size_t MiB = 1u << 20;
constexpr size_t WS_CTL = 0, CTL_ZERO_BYTES = 64 * 1024;
constexpr size_t WS_WE_IN = 2 * MiB, WS_WE_OUT = 7 * MiB, WS_WO_IN = 9 * MiB, WS_WO_OUT = 13 * MiB, WS_WF_IN = 15 * MiB  , WS_WF_OUT = 37 * MiB  ;
constexpr size_t WS_POOLWT = 49 * MiB, WS_STATS = 50 * MiB, WS_XN = 52 * MiB, WS_GLU = 86 * MiB, WS_Q = 103 * MiB, WS_K = 120 * MiB, WS_V = 137 * MiB, WS_AB = 154 * MiB, WS_ACT = 188 * MiB, WS_LO = 282 * MiB, WS_END = 316 * MiB;
constexpr size_t WS_GB = WS_GLU, WS_CX = WS_Q, WS_U = WS_K, WS_CDD = WS_AB;
static_assert(WS_LO == pg8::XWS_LO && WS_LO + (size_t)MT * DM * 2 <= WS_END && WS_STATS == pg8::XWS_STATS && WS_XN == pg8::XWS_XN && WS_GLU == pg8::XWS_GLU && WS_Q == pg8::XWS_Q && WS_K == pg8::XWS_K && WS_V == pg8::XWS_V && WS_AB == pg8::XWS_AB && WS_ACT == pg8::XWS_ACT && O_KP == pg8::XO_KP && O_VS == pg8::XO_VS, "maps");
static_assert(WS_XN + (size_t)MT * DM * 2 <= WS_GLU && WS_GLU + (size_t)MT * 512 * 2 <= WS_Q && WS_AB + (size_t)MT * DM * 2 <= WS_ACT && WS_ACT + (size_t)MT * FFN * 2 <= WS_LO, "d_ws map");
constexpr int CW_BAR = 4096;
static_assert((CW_BAR + 3456) * 4 <= (int)CTL_ZERO_BYTES, "barrier words inside the zeroed region");

constexpr int RING_OFF = 0, RING_BYTES = 139264;
constexpr int LDSCTL_OFF = RING_BYTES, MISC_OFF = LDSCTL_OFF + 320;
constexpr int LDS_BYTES = 147456;
static_assert(MISC_OFF + 128 <= LDS_BYTES, "LDS map");

#define GAS __attribute__((address_space(1)))
#define LAS __attribute__((address_space(3)))
typedef unsigned short bf16;
typedef unsigned v4u __attribute__((ext_vector_type(4)));
typedef unsigned v2u __attribute__((ext_vector_type(2)));
typedef float f32x4 __attribute__((ext_vector_type(4)));
typedef float f32x2 __attribute__((ext_vector_type(2)));
typedef GAS unsigned gu32;
#define RLX_AGENT __ATOMIC_RELAXED, __HIP_MEMORY_SCOPE_AGENT
#define LDS_WAIT() asm volatile("s_waitcnt lgkmcnt(0)" ::: "memory")
#define VM_WAIT() asm volatile("s_waitcnt vmcnt(0)" ::: "memory")
__device__ __forceinline__ unsigned f2bf(float f) { unsigned u = __builtin_bit_cast(unsigned, f); return (u + 0x7fffu + ((u >> 16) & 1u)) >> 16; }
__device__ __forceinline__ unsigned pk2(float lo, float hi) { return f2bf(lo) | (f2bf(hi) << 16); }
__device__ __forceinline__ float bf2f(unsigned b) { return __builtin_bit_cast(float, b << 16); }
__device__ __forceinline__ float bflo(unsigned w) { return __builtin_bit_cast(float, w << 16); }
__device__ __forceinline__ float bfhi(unsigned w) { return __builtin_bit_cast(float, w & 0xffff0000u); }
__device__ __forceinline__ float ex2(float x) { return __builtin_amdgcn_exp2f(x); }
__device__ __forceinline__ float lg2(float x) { return __builtin_amdgcn_logf(x); }
__device__ __forceinline__ float sigm(float x) { return __builtin_amdgcn_rcpf(1.0f + ex2(-LOG2E * x)); }

#define XB_TMO      128
#define XB_XCNT(j)  (256  + 64 * (j))
#define XB_XSUB(j)  (1280 + 64 * (j))
#define XB_XGEN(j)  (2304 + 64 * (j))
#define XB_TOP      3328
#define XB_TOPGEN   3392
#define XCD_BAR_WORDS 3456
#define XB_SPIN_CAP (1u << 18)

__device__ __forceinline__ unsigned xb_ld(unsigned* p)              { return __hip_atomic_load(p, __ATOMIC_RELAXED, __HIP_MEMORY_SCOPE_AGENT); }
__device__ __forceinline__ unsigned xb_add(unsigned* p, unsigned v) { return __hip_atomic_fetch_add(p, v, __ATOMIC_RELAXED, __HIP_MEMORY_SCOPE_AGENT); }
__device__ __forceinline__ unsigned xb_xcc_id() { return (unsigned)__builtin_amdgcn_s_getreg((3 << 11) | 20) & 0xFu; }
#define XB_SPIN(cond, bar) do { unsigned _sp = 0; while (cond) { __builtin_amdgcn_s_sleep(1); \
    if ((++_sp & 255u) == 0u) { if (xb_ld(&(bar)[XB_TMO])) break; if (_sp > XB_SPIN_CAP) { atomicAdd(&(bar)[XB_TMO], 1u); break; } } } } while (0)

struct XcdBarrier {
    unsigned* bar; unsigned x; int wv;
    volatile LAS unsigned* st;
};

__device__ __forceinline__ bool xb_thread0(int wv) { unsigned l; asm volatile("v_mbcnt_lo_u32_b32 %0, -1, 0\n\tv_mbcnt_hi_u32_b32 %0, -1, %0" : "=v"(l)); return wv == 0 && l == 0u; }
__device__ __forceinline__ XcdBarrier xcd_barrier_post(unsigned* bar, volatile LAS unsigned* st, int wv) {
    XcdBarrier b; b.bar = bar; b.x = xb_xcc_id(); b.st = st; b.wv = wv;
    if (xb_thread0(wv)) (void)xb_add(&bar[XB_XCNT(b.x)], 1u);
    return b;
}
__device__ __forceinline__ void xcd_barrier_complete(unsigned* bar, unsigned x, unsigned& nloc, unsigned& nx) {
    const unsigned G = gridDim.x * gridDim.y * gridDim.z;
    unsigned sum, cnt, mine, sp = 0u;
    for (;;) {
        sum = 0u; cnt = 0u; mine = 0u;
#pragma unroll
        for (unsigned j = 0; j < 16; ++j) { const unsigned c = xb_ld(&bar[XB_XCNT(j)]); sum += c; cnt += (c > 0u) ? 1u : 0u; mine = (j == x) ? c : mine; }
        if (sum == G) break;
        __builtin_amdgcn_s_sleep(1);
        if ((++sp & 255u) == 0u) { if (xb_ld(&bar[XB_TMO])) break; if (sp > XB_SPIN_CAP) { atomicAdd(&bar[XB_TMO], 1u); break; } }
    }
    nloc = mine > 0u ? mine : 1u; nx = cnt > 0u ? cnt : 1u;
}

__device__ __forceinline__ void xcd_barrier(const XcdBarrier& b) {
    asm volatile("s_waitcnt vmcnt(0)" ::: "memory");
    __syncthreads();
    if (xb_thread0(b.wv)) {
        unsigned* bar = b.bar;
        __builtin_amdgcn_s_waitcnt(0);
        unsigned nloc = b.st[0], nx = b.st[1];
        if (nloc == 0u) { xcd_barrier_complete(bar, b.x, nloc, nx); b.st[0] = nloc; b.st[1] = nx; }
        const unsigned old = xb_add(&bar[XB_XSUB(b.x)], 1u);
        const unsigned gen = old / nloc;
        if (old + 1u == (gen + 1u) * nloc) {
            __builtin_amdgcn_fence(__ATOMIC_RELEASE, "agent");
            asm volatile("s_waitcnt vmcnt(0)" ::: "memory");
            const unsigned og = xb_add(&bar[XB_TOP], 1u);
            const unsigned tg = og / nx;
            if (og + 1u == (tg + 1u) * nx) xb_add(&bar[XB_TOPGEN], 1u);
            else XB_SPIN(xb_ld(&bar[XB_TOPGEN]) == tg, bar);
            __builtin_amdgcn_fence(__ATOMIC_ACQUIRE, "agent");
            xb_add(&bar[XB_XGEN(b.x)], 1u);
            asm volatile("s_waitcnt vmcnt(0)" ::: "memory");
        } else {
            XB_SPIN(xb_ld(&bar[XB_XGEN(b.x)]) == gen, bar);
            __builtin_amdgcn_fence(__ATOMIC_ACQUIRE, "agent");
            asm volatile("s_waitcnt vmcnt(0)" ::: "memory");
        }
    }
    __syncthreads();
}
namespace sba {
using bf16x8 = __attribute__((ext_vector_type(8))) short;
using s16x4 = __attribute__((ext_vector_type(4))) short;
using f32x16 = __attribute__((ext_vector_type(16))) float;
using u32x4 = __attribute__((ext_vector_type(4))) unsigned;
constexpr int NSLOT = 3, SLOTB = 8192, L_K = 0, L_V = NSLOT * SLOTB, L_OST = 2 * NSLOT * SLOTB, L_BYTES = L_OST + 8 * 4096;
constexpr int PQ = 512, PO = 1024;
__device__ __forceinline__ int crow(int r, int hi) { return (r & 3) + 8 * (r >> 2) + 4 * hi; }
__device__ __forceinline__ void glds16(const void* gbase  , unsigned voff  , unsigned lds_dst) { unsigned keep;
    asm volatile("s_mov_b32 %0, m0\n\ts_mov_b32 m0, %3\n\ts_nop 0\n\tglobal_load_lds_dwordx4 %1, %2\n\ts_mov_b32 m0, %0" : "=&s"(keep) : "v"(voff), "s"(gbase), "s"(lds_dst) : "memory"); }
__device__ __forceinline__ int fresh_lane() { int l; asm volatile("v_mbcnt_lo_u32_b32 %0, -1, 0\n\tv_mbcnt_hi_u32_b32 %0, -1, %0" : "=v"(l)); return l; }
typedef float f32x2_t __attribute__((ext_vector_type(2))); typedef __bf16 bf16x2_t __attribute__((ext_vector_type(2)));
__device__ __forceinline__ unsigned cvtpk(float lo, float hi) { f32x2_t v = {lo, hi}; bf16x2_t b = __builtin_convertvector(v, bf16x2_t); return __builtin_bit_cast(unsigned, b); }
#define SBA_WAIT_BAR(N) asm volatile("s_waitcnt vmcnt(" #N ") lgkmcnt(0)\n\ts_barrier" ::: "memory")
typedef __attribute__((address_space(3))) const char* lcp;
__device__ __forceinline__ void qkt(f32x16& p0, f32x16& p1, lcp Kslot, const bf16x8* qr, const f32x16& cin, int r32, int hi) {
    lcp kb = Kslot + hi * 1024 + r32 * 16;
#pragma unroll
    for (int d0 = 0; d0 < 4; ++d0) {
        const bf16x8 b0 = *(const __attribute__((address_space(3))) bf16x8*)(kb + d0 * 2048);
        const bf16x8 b1 = *(const __attribute__((address_space(3))) bf16x8*)(kb + d0 * 2048 + 512);
        if (d0 == 0) { p0 = __builtin_amdgcn_mfma_f32_32x32x16_bf16(b0, qr[0], cin, 0, 0, 0); p1 = __builtin_amdgcn_mfma_f32_32x32x16_bf16(b1, qr[0], cin, 0, 0, 0); }
        else { p0 = __builtin_amdgcn_mfma_f32_32x32x16_bf16(b0, qr[d0], p0, 0, 0, 0); p1 = __builtin_amdgcn_mfma_f32_32x32x16_bf16(b1, qr[d0], p1, 0, 0, 0); } }
}
__device__ __forceinline__ void pv(f32x16* o, int vb, bf16x8 pa0, bf16x8 pa1, bf16x8 pa2, bf16x8 pa3) {
#pragma unroll
    for (int d0 = 0; d0 < 2; ++d0) { s16x4 lo[4], hi[4];
#pragma unroll
        for (int ks = 0; ks < 4; ++ks) {
            asm volatile("ds_read_b64_tr_b16 %0,%1 offset:%c2" : "=&v"(lo[ks]) : "v"(vb), "i"(d0 * 4096 + ks * 1024) : "memory");
            asm volatile("ds_read_b64_tr_b16 %0,%1 offset:%c2" : "=&v"(hi[ks]) : "v"(vb), "i"(d0 * 4096 + ks * 1024 + 512) : "memory"); }
        asm volatile("s_waitcnt lgkmcnt(0)" ::: "memory"); __builtin_amdgcn_sched_barrier(0);
#define SBA_PK(k) (bf16x8){lo[k][0], lo[k][1], lo[k][2], lo[k][3], hi[k][0], hi[k][1], hi[k][2], hi[k][3]}
        o[d0] = __builtin_amdgcn_mfma_f32_32x32x16_bf16(pa0, SBA_PK(0), o[d0], 0, 0, 0);
        o[d0] = __builtin_amdgcn_mfma_f32_32x32x16_bf16(pa1, SBA_PK(1), o[d0], 0, 0, 0);
        o[d0] = __builtin_amdgcn_mfma_f32_32x32x16_bf16(pa2, SBA_PK(2), o[d0], 0, 0, 0);
        o[d0] = __builtin_amdgcn_mfma_f32_32x32x16_bf16(pa3, SBA_PK(3), o[d0], 0, 0, 0);
#undef SBA_PK
    }
}
__device__ __forceinline__ float sp2(float z) { return fmaxf(z, 0.f) + __builtin_amdgcn_logf(1.0f + __builtin_amdgcn_exp2f(-__builtin_fabsf(z))); }
template <bool BAND> __device__ __forceinline__ void sb_tile(f32x16& p0, f32x16& p1, float& A, u32x4 (&pw)[4], int kv0, int qabs, int hi, float hsel) {
    float s0[16], s1[16];
#pragma unroll
    for (int r = 0; r < 16; ++r) { s0[r] = sp2(p0[r]); s1[r] = sp2(p1[r]);
        if (BAND) { const int kv = kv0 + crow(r, hi); if (kv >= qabs) s0[r] = 0.f; if (kv + 32 >= qabs) s1[r] = 0.f; } }
    float glo[8], ghi[8];
#pragma unroll
    for (int g = 0; g < 4; ++g) {
        const float a = (s0[4 * g] + s0[4 * g + 1]) + (s0[4 * g + 2] + s0[4 * g + 3]), b = (s1[4 * g] + s1[4 * g + 1]) + (s1[4 * g + 2] + s1[4 * g + 3]);
        auto ra = __builtin_amdgcn_permlane32_swap(__float_as_uint(a), __float_as_uint(a), false, false);
        auto rb = __builtin_amdgcn_permlane32_swap(__float_as_uint(b), __float_as_uint(b), false, false);
        glo[g] = __uint_as_float(ra[0]); ghi[g] = __uint_as_float(ra[1]); glo[4 + g] = __uint_as_float(rb[0]); ghi[4 + g] = __uint_as_float(rb[1]); }
    float run = A;
#pragma unroll
    for (int G = 7; G >= 0; --G) {
        float c = run + hsel * ghi[G];
        if (G < 4) {
#pragma unroll
            for (int i = 3; i >= 0; --i) { c += s0[4 * G + i]; const float w = __builtin_amdgcn_exp2f(p0[4 * G + i] - c); p0[4 * G + i] = w; }
        } else {
#pragma unroll
            for (int i = 3; i >= 0; --i) { c += s1[4 * (G - 4) + i]; const float w = __builtin_amdgcn_exp2f(p1[4 * (G - 4) + i] - c); p1[4 * (G - 4) + i] = w; }
        }
        run += glo[G] + ghi[G];
    }
    A = run;
    if (BAND) {
#pragma unroll
        for (int r = 0; r < 16; ++r) { const int kv = kv0 + crow(r, hi); if (kv >= qabs) p0[r] = 0.f; if (kv + 32 >= qabs) p1[r] = 0.f; }
    }
#pragma unroll
    for (int k = 0; k < 2; ++k) {
        pw[k] = (u32x4){cvtpk(p0[8 * k], p0[8 * k + 1]), cvtpk(p0[8 * k + 2], p0[8 * k + 3]), cvtpk(p0[8 * k + 4], p0[8 * k + 5]), cvtpk(p0[8 * k + 6], p0[8 * k + 7])};
        pw[2 + k] = (u32x4){cvtpk(p1[8 * k], p1[8 * k + 1]), cvtpk(p1[8 * k + 2], p1[8 * k + 3]), cvtpk(p1[8 * k + 4], p1[8 * k + 5]), cvtpk(p1[8 * k + 6], p1[8 * k + 7])}; }
}
__device__ __forceinline__ void bar4(__attribute__((address_space(3))) unsigned* cnt, unsigned& target, int lane) {
    target += 4u;
    if (lane == 0) __hip_atomic_fetch_add((unsigned*)cnt, 1u, __ATOMIC_RELAXED, __HIP_MEMORY_SCOPE_WORKGROUP);
    for (unsigned sp = 0; *(volatile __attribute__((address_space(3))) unsigned*)cnt < target && sp < (1u << 22); ++sp) __builtin_amdgcn_s_sleep(1);
    asm volatile("" ::: "memory");
}
constexpr int L_BAR4 = L_OST + 8 * 4096;
template <int NW> __device__ __forceinline__ void unitT(int b, int h, int qb, const unsigned short* Q, const unsigned short* K, const unsigned short* V, unsigned short* O, float bias2,
                                     __attribute__((address_space(3))) unsigned char* shm, int wid, unsigned& btarget) {
    constexpr int QB = 32 * NW, PCS = 8 / NW;
    const int lane = fresh_lane(); const int r32 = lane & 31, hi = lane >> 5;
    const long rowbase = (long)b * 2048; const int q0 = qb * QB;
    const unsigned short* Qw = Q + (rowbase + q0 + wid * 32) * PQ + h * 64;
    const unsigned short* Kh = K + rowbase * PQ + h * 64; const unsigned short* Vh = V + rowbase * PQ + h * 64;
    const unsigned lds0 = (unsigned)(uintptr_t)shm;
    __attribute__((address_space(3))) unsigned* bcnt = (__attribute__((address_space(3))) unsigned*)(shm + L_BAR4);
    const unsigned koffL = (unsigned)(lane * PQ) * 2u, voffL = (unsigned)((lane >> 2) * PQ + (lane & 3) * 8) * 2u;
#define SBA_DMA(t, slot) do { _Pragma("unroll") for (int pc_ = 0; pc_ < PCS; ++pc_) { const int pc = wid + NW * pc_; \
        glds16(Kh + (long)(t) * 64 * PQ + pc * 8, koffL, (unsigned)__builtin_amdgcn_readfirstlane(lds0 + L_K + pc * 1024 + (slot))); \
        glds16(Vh + (long)(t) * 64 * PQ + (long)(16 * (pc & 3)) * PQ + (pc >> 2) * 32, voffL, (unsigned)__builtin_amdgcn_readfirstlane(lds0 + L_V + pc * 1024 + (slot))); } } while (0)
#define SBA_SYNC() do { if constexpr (NW == 8) { asm volatile("s_barrier" ::: "memory"); } else { bar4(bcnt, btarget, lane); } } while (0)
    const int vb0 = (int)(lds0 + L_V) + ((lane >> 4) & 1) * 32 + (lane & 3) * 8 + (4 * hi + ((lane & 15) >> 2)) * 64;
    const lcp shm3 = (lcp)shm;
    const int NT = (q0 + QB) / 64;
    bf16x8 qr[4];
#pragma unroll
    for (int d0 = 0; d0 < 4; ++d0) qr[d0] = *reinterpret_cast<const bf16x8*>(&Qw[(long)r32 * PQ + d0 * 16 + hi * 8]);
    SBA_DMA(NT - 1, 0); SBA_DMA(NT - 2, SLOTB);
    float A = 0.f; f32x16 o[2]; o[0] = f32x16{}; o[1] = f32x16{};
    f32x16 cin;
#pragma unroll
    for (int r = 0; r < 16; ++r) cin[r] = bias2;
    const int qabs = q0 + wid * 32 + r32, qmin = q0 + wid * 32;
    const float hsel = hi == 0 ? 1.f : 0.f;
    int slot = 0, slot2 = 2 * SLOTB;
    for (int i = 0; i < NT; ++i) {
        const int t = NT - 1 - i;
        if (i + 1 < NT) { if constexpr (NW == 8) asm volatile("s_waitcnt vmcnt(2) lgkmcnt(0)" ::: "memory"); else asm volatile("s_waitcnt vmcnt(4) lgkmcnt(0)" ::: "memory"); }
        else asm volatile("s_waitcnt vmcnt(0) lgkmcnt(0)" ::: "memory");
        SBA_SYNC();
        if (i + 2 < NT) SBA_DMA(t - 2, slot2);
        const int kv0 = 64 * t;
        if (kv0 < qmin + 31) {
            f32x16 p0, p1; u32x4 pw[4];
            qkt(p0, p1, shm3 + L_K + slot, qr, cin, r32, hi);
            if (kv0 + 63 >= qmin) sb_tile<true>(p0, p1, A, pw, kv0, qabs, hi, hsel); else sb_tile<false>(p0, p1, A, pw, kv0, qabs, hi, hsel);
            pv(o, vb0 + slot, __builtin_bit_cast(bf16x8, pw[0]), __builtin_bit_cast(bf16x8, pw[1]), __builtin_bit_cast(bf16x8, pw[2]), __builtin_bit_cast(bf16x8, pw[3]));
        }
        slot = slot == 2 * SLOTB ? 0 : slot + SLOTB; slot2 = slot2 == 2 * SLOTB ? 0 : slot2 + SLOTB;
    }
    unsigned short* Ow = O + (rowbase + q0 + wid * 32) * PO + h * 64;
    { const int lane = fresh_lane(); const int r32 = lane & 31, hi = lane >> 5; __attribute__((address_space(3))) unsigned short* stg = (__attribute__((address_space(3))) unsigned short*)(shm + L_OST) + wid * 2048;
#pragma unroll
        for (int r = 0; r < 16; ++r) { const int orow = crow(r, hi);
#pragma unroll
            for (int d0 = 0; d0 < 2; ++d0) stg[orow * 64 + d0 * 32 + r32] = (unsigned short)(cvtpk(o[d0][r], 0.f) & 0xffffu); }
        asm volatile("s_waitcnt lgkmcnt(0)" ::: "memory");
#pragma unroll
        for (int i = 0; i < 4; ++i) { const int row = i * 8 + (lane >> 3), ch = lane & 7; const u32x4 v = *(const __attribute__((address_space(3))) u32x4*)(stg + row * 64 + ch * 8); *(u32x4*)(Ow + (long)row * PO + ch * 8) = v; } }
    asm volatile("s_waitcnt lgkmcnt(0)" ::: "memory");
    SBA_SYNC();
#undef SBA_DMA
#undef SBA_SYNC
}
constexpr int P4_RK = 4, P4_RV = 5, P4_LV = P4_RK * SLOTB, P4_BAR = (P4_RK + P4_RV) * SLOTB, P4_BYTES = P4_BAR + 256;
__device__ __forceinline__ void unitP4(int b, int h, int qb, const unsigned short* Q, const unsigned short* K, const unsigned short* V, unsigned short* O, float bias2,
                                       __attribute__((address_space(3))) unsigned char* shm, int wid, unsigned& btarget) {
    const int lane = fresh_lane(); const int r32 = lane & 31, hi = lane >> 5;
    const long rowbase = (long)b * 2048; const int q0 = qb * 128;
    const unsigned short* Qw = Q + (rowbase + q0 + wid * 32) * PQ + h * 64;
    const unsigned short* Kh = K + rowbase * PQ + h * 64; const unsigned short* Vh = V + rowbase * PQ + h * 64;
    const unsigned lds0 = (unsigned)(uintptr_t)shm;
    __attribute__((address_space(3))) unsigned* bcnt = (__attribute__((address_space(3))) unsigned*)(shm + P4_BAR);
    const int NT = (q0 + 128) / 64;
#define P4_DMA(j, ks, vs) do { const long t_ = (long)(NT - 1 - (j)); const int ln_ = fresh_lane(); const unsigned koffL = (unsigned)(ln_ * PQ) * 2u, voffL = (unsigned)((ln_ >> 2) * PQ + (ln_ & 3) * 8) * 2u;     _Pragma("unroll") for (int pc_ = 0; pc_ < 2; ++pc_) { const int pc = wid + 4 * pc_; \
        glds16(Kh + t_ * 64 * PQ + pc * 8, koffL, (unsigned)__builtin_amdgcn_readfirstlane(lds0 + pc * 1024 + (ks))); \
        glds16(Vh + t_ * 64 * PQ + (long)(16 * (pc & 3)) * PQ + (pc >> 2) * 32, voffL, (unsigned)__builtin_amdgcn_readfirstlane(lds0 + P4_LV + pc * 1024 + (vs))); } } while (0)
#define P4_WAIT(i) do { if ((i) + 2 < NT) asm volatile("s_waitcnt vmcnt(4) lgkmcnt(0)" ::: "memory"); else asm volatile("s_waitcnt vmcnt(0) lgkmcnt(0)" ::: "memory"); bar4(bcnt, btarget, lane); } while (0)
    const int vb0 = (int)(lds0 + P4_LV) + ((lane >> 4) & 1) * 32 + (lane & 3) * 8 + (4 * hi + ((lane & 15) >> 2)) * 64;
    const lcp shm3 = (lcp)shm;
    bf16x8 qr[4];
#pragma unroll
    for (int d0 = 0; d0 < 4; ++d0) qr[d0] = *reinterpret_cast<const bf16x8*>(&Qw[(long)r32 * PQ + d0 * 16 + hi * 8]);
    P4_DMA(0, 0, 0); P4_DMA(1, SLOTB, SLOTB); if (NT > 2) P4_DMA(2, 2 * SLOTB, 2 * SLOTB);
    float A = 0.f; f32x16 o[2]; o[0] = f32x16{}; o[1] = f32x16{};
    f32x16 cin;
#pragma unroll
    for (int r = 0; r < 16; ++r) cin[r] = bias2;
    const int qabs = q0 + wid * 32 + r32, qmin = q0 + wid * 32;
    const float hsel = hi == 0 ? 1.f : 0.f;
    int ks3 = 3 * SLOTB, vs3 = 3 * SLOTB;
#define P4_ADV() do { ks3 = ks3 == (P4_RK - 1) * SLOTB ? 0 : ks3 + SLOTB; vs3 = vs3 == (P4_RV - 1) * SLOTB ? 0 : vs3 + SLOTB; } while (0)
#pragma nounroll
    for (int i = 0; i < 2; ++i) {
        P4_WAIT(i);
        if (i + 3 < NT) P4_DMA(i + 3, ks3, vs3);
        P4_ADV();
        const int kv0 = 64 * (NT - 1 - i);
        if (kv0 < qmin + 31) {
            f32x16 p0, p1; u32x4 pw[4];
            qkt(p0, p1, shm3 + i * SLOTB, qr, cin, r32, hi);
            if (kv0 + 63 >= qmin) sb_tile<true>(p0, p1, A, pw, kv0, qabs, hi, hsel); else sb_tile<false>(p0, p1, A, pw, kv0, qabs, hi, hsel);
            pv(o, vb0 + i * SLOTB, __builtin_bit_cast(bf16x8, pw[0]), __builtin_bit_cast(bf16x8, pw[1]), __builtin_bit_cast(bf16x8, pw[2]), __builtin_bit_cast(bf16x8, pw[3]));
        }
    }
    if (NT > 2) {
        f32x16 zc0, zc1; u32x4 pw[4];
#pragma unroll
        for (int k = 0; k < 4; ++k) pw[k] = (u32x4){0u, 0u, 0u, 0u};
        qkt(zc0, zc1, shm3 + 2 * SLOTB, qr, cin, r32, hi);
        int kcur = 2 * SLOTB, vcur = 2 * SLOTB, vprev = SLOTB;
#pragma nounroll
        for (int i = 2; i < NT; ++i) {
            P4_WAIT(i);
            if (i + 3 < NT) P4_DMA(i + 3, ks3, vs3);
            P4_ADV();
            const int knext = (i + 1 < NT) ? (kcur == (P4_RK - 1) * SLOTB ? 0 : kcur + SLOTB) : kcur;
            f32x16 zn0, zn1;
            qkt(zn0, zn1, shm3 + knext, qr, cin, r32, hi);
            pv(o, vb0 + vprev, __builtin_bit_cast(bf16x8, pw[0]), __builtin_bit_cast(bf16x8, pw[1]), __builtin_bit_cast(bf16x8, pw[2]), __builtin_bit_cast(bf16x8, pw[3]));
            sb_tile<false>(zc0, zc1, A, pw, 64 * (NT - 1 - i), qabs, hi, hsel);
            zc0 = zn0; zc1 = zn1; vprev = vcur; kcur = knext; vcur = vcur == (P4_RV - 1) * SLOTB ? 0 : vcur + SLOTB;
        }
        pv(o, vb0 + vprev, __builtin_bit_cast(bf16x8, pw[0]), __builtin_bit_cast(bf16x8, pw[1]), __builtin_bit_cast(bf16x8, pw[2]), __builtin_bit_cast(bf16x8, pw[3]));
    }
    asm volatile("s_waitcnt lgkmcnt(0)" ::: "memory");
    bar4(bcnt, btarget, lane);
    unsigned short* Ow = O + (rowbase + q0 + wid * 32) * PO + h * 64;
    { const int lane = fresh_lane(); const int r32 = lane & 31, hi = lane >> 5; __attribute__((address_space(3))) unsigned short* stg = (__attribute__((address_space(3))) unsigned short*)shm + wid * 2048;
#pragma unroll
        for (int r = 0; r < 16; ++r) { const int orow = crow(r, hi);
#pragma unroll
            for (int d0 = 0; d0 < 2; ++d0) stg[orow * 64 + d0 * 32 + r32] = (unsigned short)(cvtpk(o[d0][r], 0.f) & 0xffffu); }
        asm volatile("s_waitcnt lgkmcnt(0)" ::: "memory");
#pragma unroll
        for (int i = 0; i < 4; ++i) { const int row = i * 8 + (lane >> 3), ch = lane & 7; const u32x4 v = *(const __attribute__((address_space(3))) u32x4*)(stg + row * 64 + ch * 8); *(u32x4*)(Ow + (long)row * PO + ch * 8) = v; } }
    asm volatile("s_waitcnt lgkmcnt(0)" ::: "memory");
    bar4(bcnt, btarget, lane);
#undef P4_DMA
#undef P4_WAIT
#undef P4_ADV
}
#undef SBA_WAIT_BAR
}

namespace sbs {
using bf16x8 = __attribute__((ext_vector_type(8))) short;
using s16x4 = __attribute__((ext_vector_type(4))) short;
using f32x4 = __attribute__((ext_vector_type(4))) float;
using u32x2 = __attribute__((ext_vector_type(2))) unsigned;
using u32x4 = __attribute__((ext_vector_type(4))) unsigned;
#define SLAS __attribute__((address_space(3)))
constexpr int ROWB = 144, VT_BYTES = 32 * ROWB  , L_KT = 8 * VT_BYTES, L_COMB = 16 * VT_BYTES  , L_BYTES = L_COMB + 4 * 64 * 16 * 4, L_SOLO_BYTES = L_KT + 4 * VT_BYTES;
struct Regs { f32x4 k[8]; f32x4 v[8]; };
__device__ __forceinline__ unsigned pk(float a, float b) { return sba::cvtpk(a, b); }
__device__ __forceinline__ bf16x8 pack8(const f32x4 a, const f32x4 b) { u32x4 w = {pk(a[0], a[1]), pk(a[2], a[3]), pk(b[0], b[1]), pk(b[2], b[3])}; return __builtin_bit_cast(bf16x8, w); }
__device__ __forceinline__ void load_step(Regs& R, const float* kp, const float* vp, int s, int l15, int fq) {
    const float* kr = kp + (size_t)(32 * s + fq) * 512 + 4 * l15;
    const float* vr = vp + (size_t)(32 * s + fq) * 512 + 4 * l15;
#pragma unroll
    for (int u = 0; u < 8; ++u) R.k[u] = __builtin_nontemporal_load((const f32x4*)(kr + (size_t)u * 4 * 512));
#pragma unroll
    for (int u = 0; u < 8; ++u) R.v[u] = __builtin_nontemporal_load((const f32x4*)(vr + (size_t)u * 4 * 512));
}
__device__ __forceinline__ void sb16(f32x4& z, float& A, int fq, bool v0, bool v1, bool v2, bool v3) {
    float s[4] = {v0 ? sba::sp2(z[0]) : 0.f, v1 ? sba::sp2(z[1]) : 0.f, v2 ? sba::sp2(z[2]) : 0.f, v3 ? sba::sp2(z[3]) : 0.f};
    const float gs = (s[0] + s[1]) + (s[2] + s[3]);
    const auto a16 = __builtin_amdgcn_permlane16_swap(__float_as_uint(gs), __float_as_uint(gs), false, false);
    const auto e32 = __builtin_amdgcn_permlane32_swap(a16[0], a16[0], false, false);
    const auto o32 = __builtin_amdgcn_permlane32_swap(a16[1], a16[1], false, false);
    const float v0_ = __uint_as_float(e32[0]), v1_ = __uint_as_float(o32[0]), v2_ = __uint_as_float(e32[1]), v3_ = __uint_as_float(o32[1]);
    const float s2_ = v2_ + v3_, s1_ = v1_ + s2_;
    const float after = fq == 0 ? s1_ : (fq == 1 ? s2_ : (fq == 2 ? v3_ : 0.f));
    float c = A + after;
    c += s[3]; const float w3 = v3 ? __builtin_amdgcn_exp2f(z[3] - c) : 0.f;
    c += s[2]; const float w2 = v2 ? __builtin_amdgcn_exp2f(z[2] - c) : 0.f;
    c += s[1]; const float w1 = v1 ? __builtin_amdgcn_exp2f(z[1] - c) : 0.f;
    c += s[0]; const float w0 = v0 ? __builtin_amdgcn_exp2f(z[0] - c) : 0.f;
    z = (f32x4){w0, w1, w2, w3};
    A += v0_ + s1_;
}
__device__ __forceinline__ void pv_step(f32x4 (&O)[4], unsigned vt_rd, bf16x8 wb) {
    s16x4 lo[4], hi[4];
#pragma unroll
    for (int md = 0; md < 4; ++md) {
        asm volatile("ds_read_b64_tr_b16 %0,%1 offset:%c2" : "=&v"(lo[md]) : "v"(vt_rd), "i"(md * 32) : "memory");
        asm volatile("ds_read_b64_tr_b16 %0,%1 offset:%c2" : "=&v"(hi[md]) : "v"(vt_rd), "i"(md * 32 + 16 * ROWB) : "memory"); }
    asm volatile("s_waitcnt lgkmcnt(0)" ::: "memory"); __builtin_amdgcn_sched_barrier(0);
#pragma unroll
    for (int md = 0; md < 4; ++md) { const bf16x8 a = (bf16x8){lo[md][0], lo[md][1], lo[md][2], lo[md][3], hi[md][0], hi[md][1], hi[md][2], hi[md][3]};
        O[md] = __builtin_amdgcn_mfma_f32_16x16x32_bf16(a, wb, O[md], 0, 0, 0); }
}
__device__ __forceinline__ void consume_step(const Regs& R, bf16x8 (&kf)[4], SLAS unsigned char* kt, SLAS unsigned char* vt, unsigned vt_wr, unsigned kt_rd) {
#pragma unroll
    for (int u = 0; u < 8; ++u) { const u32x2 w = {pk(R.k[u][0], R.k[u][1]), pk(R.k[u][2], R.k[u][3])}; *(SLAS u32x2*)(kt + vt_wr + u * 4 * ROWB) = w; }
#pragma unroll
    for (int u = 0; u < 8; ++u) { const u32x2 w = {pk(R.v[u][0], R.v[u][1]), pk(R.v[u][2], R.v[u][3])}; *(SLAS u32x2*)(vt + vt_wr + u * 4 * ROWB) = w; }
#pragma unroll
    for (int g = 0; g < 2; ++g)
#pragma unroll
        for (int kk = 0; kk < 2; ++kk) kf[2 * g + kk] = *(const SLAS bf16x8*)(kt + kt_rd + g * 16 * ROWB + kk * 64);
}
__device__ __forceinline__ void math_step(const bf16x8 (&kf)[4], const bf16x8 (&qf)[2], const f32x4 cin, float& A, f32x4 (&O)[4], unsigned vt_rd, int fq) {
    f32x4 z[2];
#pragma unroll
    for (int g = 0; g < 2; ++g) { z[g] = __builtin_amdgcn_mfma_f32_16x16x32_bf16(kf[2 * g], qf[0], cin, 0, 0, 0);
        z[g] = __builtin_amdgcn_mfma_f32_16x16x32_bf16(kf[2 * g + 1], qf[1], z[g], 0, 0, 0); }
    sb16(z[1], A, fq, true, true, true, true);
    sb16(z[0], A, fq, true, true, true, true);
    pv_step(O, vt_rd, pack8(z[0], z[1]));
}
template <bool SOLO> __device__ __forceinline__ void unit(int b, int hg, const unsigned short* Q, const unsigned short* Kn, const unsigned short* Vn, const float* ck, const float* cv, const int* pt, const float* sbias,
                                     unsigned short* AB, SLAS unsigned char* shm, int wid) {
    const int lane = sba::fresh_lane(); const int l15 = lane & 15, fq = lane >> 4;
    const int h = 4 * hg + (wid & 3), half = SOLO ? 0 : (wid >> 2);
    constexpr int NSTEP = SOLO ? 64 : 32;
    const int row0 = 16384 + 8 * b;
    SLAS unsigned char* vt = shm + wid * VT_BYTES; SLAS unsigned char* kt = shm + L_KT + wid * VT_BYTES;
    const unsigned kt_rd = (unsigned)(l15 * ROWB + fq * 16);
    const unsigned vt_wr = (unsigned)(fq * ROWB + l15 * 8);
    const unsigned vt_rd = (unsigned)(uintptr_t)vt + (unsigned)((4 * fq + (l15 >> 2)) * ROWB + (l15 & 3) * 8);
    const float bias2 = sbias[h] * 1.4426950408889634f;
    const f32x4 cin = {bias2, bias2, bias2, bias2};
    bf16x8 qf[2];
#pragma unroll
    for (int kk = 0; kk < 2; ++kk) { u32x4 w = {0u, 0u, 0u, 0u};
        if (l15 < 8) w = *(const u32x4*)(Q + (size_t)(row0 + l15) * 512 + h * 64 + 32 * kk + 8 * fq);
        qf[kk] = __builtin_bit_cast(bf16x8, w); }
    float A = 0.f; f32x4 O[4];
#pragma unroll
    for (int md = 0; md < 4; ++md) O[md] = (f32x4){0.f, 0.f, 0.f, 0.f};
    const int pg_hi = half == 0 ? 15 : 7;
    const int ptv = pt[b * 16 + l15];
#define SBS_PAGE(pg) __builtin_amdgcn_readlane(ptv, (pg))
    Regs Ra, Rb;
    { const int page = SBS_PAGE(pg_hi); load_step(Ra, ck + (size_t)page * 65536 + h * 64, cv + (size_t)page * 65536 + h * 64, 3, l15, fq); }
    if (half == 0) {
        u32x4 ka[2];
#pragma unroll
        for (int kk = 0; kk < 2; ++kk) { ka[kk] = (u32x4){0u, 0u, 0u, 0u};
            if (l15 < 8) ka[kk] = *(const u32x4*)(Kn + (size_t)(row0 + l15) * 512 + h * 64 + 32 * kk + 8 * fq); }
#pragma unroll
        for (int u = 0; u < 8; ++u) { u32x2 w = {0u, 0u}; const int key = 4 * u + fq;
            if (key < 8) w = *(const u32x2*)(Vn + (size_t)(row0 + key) * 512 + h * 64 + 4 * l15);
            *(SLAS u32x2*)(vt + vt_wr + u * 4 * ROWB) = w; }
        f32x4 z = __builtin_amdgcn_mfma_f32_16x16x32_bf16(__builtin_bit_cast(bf16x8, ka[0]), qf[0], cin, 0, 0, 0);
        z = __builtin_amdgcn_mfma_f32_16x16x32_bf16(__builtin_bit_cast(bf16x8, ka[1]), qf[1], z, 0, 0, 0);
        const int k0 = 4 * fq;
        sb16(z, A, fq, k0 < 8 && k0 < l15, k0 + 1 < 8 && k0 + 1 < l15, k0 + 2 < 8 && k0 + 2 < l15, k0 + 3 < 8 && k0 + 3 < l15);
        asm volatile("s_waitcnt lgkmcnt(0)" ::: "memory");
        pv_step(O, vt_rd, pack8(z, (f32x4){0.f, 0.f, 0.f, 0.f}));
    }
    { const int page = SBS_PAGE(pg_hi); load_step(Rb, ck + (size_t)page * 65536 + h * 64, cv + (size_t)page * 65536 + h * 64, 2, l15, fq); }
    bf16x8 kf[4];
#pragma nounroll
    for (int it = 0; it < NSTEP; it += 2) {
        __builtin_amdgcn_sched_barrier(0);
        consume_step(Ra, kf, kt, vt, vt_wr, kt_rd);
        __builtin_amdgcn_sched_barrier(0);
        if (it + 2 < NSTEP) { const int n = it + 2; const int page = SBS_PAGE(pg_hi - (n >> 2)); load_step(Ra, ck + (size_t)page * 65536 + h * 64, cv + (size_t)page * 65536 + h * 64, 3 - (n & 3), l15, fq); }
        __builtin_amdgcn_sched_barrier(0);
        math_step(kf, qf, cin, A, O, vt_rd, fq);
        __builtin_amdgcn_sched_barrier(0);
        consume_step(Rb, kf, kt, vt, vt_wr, kt_rd);
        __builtin_amdgcn_sched_barrier(0);
        if (it + 3 < NSTEP) { const int n = it + 3; const int page = SBS_PAGE(pg_hi - (n >> 2)); load_step(Rb, ck + (size_t)page * 65536 + h * 64, cv + (size_t)page * 65536 + h * 64, 3 - (n & 3), l15, fq); }
        __builtin_amdgcn_sched_barrier(0);
        math_step(kf, qf, cin, A, O, vt_rd, fq);
        __builtin_amdgcn_sched_barrier(0);
    }
    if constexpr (SOLO) {
        if (l15 < 8) {
#pragma unroll
            for (int md = 0; md < 4; ++md) { const u32x2 w = {pk(O[md][0], O[md][1]), pk(O[md][2], O[md][3])};
                *(u32x2*)(AB + (size_t)(row0 + l15) * 1024 + 512 + h * 64 + 16 * md + 4 * fq) = w; } }
        asm volatile("s_waitcnt lgkmcnt(0)" ::: "memory");
    } else {
    SLAS f32x4* cb = (SLAS f32x4*)(shm + L_COMB) + ((wid & 3) * 64 + lane) * 4;
    if (half == 1) {
#pragma unroll
        for (int md = 0; md < 4; ++md) cb[md] = O[md]; }
    asm volatile("s_waitcnt vmcnt(0) lgkmcnt(0)" ::: "memory");
    __syncthreads();
    if (half == 0) {
        const float f = __builtin_amdgcn_exp2f(-A);
        if (l15 < 8) {
#pragma unroll
            for (int md = 0; md < 4; ++md) { const f32x4 o = O[md] + cb[md] * f; const u32x2 w = {pk(o[0], o[1]), pk(o[2], o[3])};
                *(u32x2*)(AB + (size_t)(row0 + l15) * 1024 + 512 + h * 64 + 16 * md + 4 * fq) = w; } }
    }
    asm volatile("s_waitcnt lgkmcnt(0)" ::: "memory");
    __syncthreads();
    }
}
#undef SBS_PAGE
#undef SLAS
}

namespace tg {
using bf16x8 = __attribute__((ext_vector_type(8))) short;
using f32x4 = __attribute__((ext_vector_type(4))) float;
#define TLAS __attribute__((address_space(3)))
constexpr int CSTR = 68, WBYTES = 64 * CSTR * 4, L_BYTES = 8 * WBYTES;
template <class Epi> __device__ __forceinline__ void tail_gemm(TLAS unsigned char* lds, const unsigned short* A, const unsigned short* Bt, const int K, const int n_colp, const Epi& E, const int wid, const int vcu, const int G) {
    const int lane = sba::fresh_lane(); const int l15 = lane & 15, fq = lane >> 4;
    const int kq = K >> 3, nks = kq >> 5, kw = wid * kq;
    for (int piece = vcu; piece < 16 * n_colp; piece += G) {
        const int rp = piece / n_colp, cp = piece - rp * n_colp, r0 = 16384 + 64 * rp;
        const unsigned short* ap = A + (size_t)(r0 + l15) * K + kw + 8 * fq;
        const unsigned short* bp[4];
#pragma unroll
        for (int ni = 0; ni < 4; ++ni) bp[ni] = Bt + (size_t)E.brow(cp, 16 * ni + l15) * K + kw + 8 * fq;
        f32x4 acc[4][4];
#pragma unroll
        for (int mi = 0; mi < 4; ++mi)
#pragma unroll
            for (int ni = 0; ni < 4; ++ni) acc[mi][ni] = (f32x4){0.f, 0.f, 0.f, 0.f};
#pragma nounroll
        for (int k0 = 0; k0 < nks; k0 += 4) {
            bf16x8 af[4][4], bfr[4][4];
#pragma unroll
            for (int ks = 0; ks < 4; ++ks) if (k0 + ks < nks) {
#pragma unroll
                for (int mi = 0; mi < 4; ++mi) af[ks][mi] = *(const bf16x8*)(ap + (size_t)mi * 16 * K + (k0 + ks) * 32);
#pragma unroll
                for (int ni = 0; ni < 4; ++ni) bfr[ks][ni] = *(const bf16x8*)(bp[ni] + (k0 + ks) * 32); }
#pragma unroll
            for (int ks = 0; ks < 4; ++ks) if (k0 + ks < nks) {
#pragma unroll
                for (int mi = 0; mi < 4; ++mi)
#pragma unroll
                    for (int ni = 0; ni < 4; ++ni) acc[mi][ni] = __builtin_amdgcn_mfma_f32_16x16x32_bf16(af[ks][mi], bfr[ks][ni], acc[mi][ni], 0, 0, 0); }
        }
#pragma unroll
        for (int mi = 0; mi < 4; ++mi)
#pragma unroll
            for (int ni = 0; ni < 4; ++ni) *(TLAS f32x4*)(lds + wid * WBYTES + ((16 * ni + l15) * CSTR + 4 * (4 * mi + fq)) * 4) = acc[mi][ni];
        __syncthreads();
        f32x4 s[2];
#pragma unroll
        for (int pass = 0; pass < 2; ++pass) { const int rq = wid + 8 * pass; s[pass] = (f32x4){0.f, 0.f, 0.f, 0.f};
#pragma unroll
            for (int w = 0; w < 8; ++w) s[pass] += *(const TLAS f32x4*)(lds + w * WBYTES + (lane * CSTR + 4 * rq) * 4); }
        E.piece(s, r0 + 4 * wid, cp, lane);
        __syncthreads();
    }
}
__device__ __forceinline__ float wsum(float v) {
#pragma unroll
    for (int o = 1; o < 64; o <<= 1) v += __shfl_xor(v, o);
    return v; }
__device__ __forceinline__ unsigned short f2bf16(float f) { return (unsigned short)(sba::cvtpk(f, 0.f) & 0xffffu); }
template <bool BASE_F32, bool RLO = true, bool WLO = true> struct TailRes {
    unsigned char* ws; const float* base_s  ;
    __device__ __forceinline__ int brow(int cp, int x) const { return 64 * cp + x; }
    __device__ __forceinline__ void piece(const f32x4 (&s)[2], int row0, int cp, int lane) const {
        unsigned short* HI = (unsigned short*)(ws + pg8::XWS_XN); unsigned short* LO = (unsigned short*)(ws + pg8::XWS_LO); float* stats = (float*)(ws + pg8::XWS_STATS);
        const int col = 64 * cp + lane;
        float x[8];
#pragma unroll
        for (int k = 0; k < 8; ++k) { const int row = row0 + 32 * (k >> 2) + (k & 3);
            if constexpr (BASE_F32) x[k] = base_s[(size_t)(row - 16384) * 1024 + col];
            else if constexpr (RLO) x[k] = __builtin_bit_cast(float, (unsigned)HI[(size_t)row * 1024 + col] << 16) + __builtin_bit_cast(float, (unsigned)LO[(size_t)row * 1024 + col] << 16);
            else x[k] = __builtin_bit_cast(float, (unsigned)HI[(size_t)row * 1024 + col] << 16); }
#pragma unroll
        for (int k = 0; k < 8; ++k) x[k] += s[k >> 2][k & 3];
#pragma unroll
        for (int k = 0; k < 8; ++k) { const int row = row0 + 32 * (k >> 2) + (k & 3);
            const unsigned short hi = f2bf16(x[k]); HI[(size_t)row * 1024 + col] = hi; if constexpr (WLO) LO[(size_t)row * 1024 + col] = f2bf16(x[k] - __builtin_bit_cast(float, (unsigned)hi << 16));
            const float ss = wsum(x[k] * x[k]);
            if (lane == 0) stats[(size_t)row * 16 + cp] = ss; }
    }
};
using TailRes0 = TailRes<true, false, false>; using TailResM = TailRes<false, false, false>; using TailResL = TailRes<false, false, true>;
struct TailInOdd {
    unsigned char* ws;
    __device__ __forceinline__ int brow(int cp, int x) const {
        if (cp < 8) return 64 * cp + x;
        if (cp < 24) { const int j = cp - 8, base = 512 + 256 * (j >> 2) + 32 * (j & 3); return x < 32 ? base + x : base + 128 + (x - 32); }
        return 1536 + 64 * (cp - 24) + x; }
    __device__ __forceinline__ void piece(const f32x4 (&s)[2], int row0, int cp, int lane) const {
        const float* stats = (const float*)(ws + pg8::XWS_STATS);
        unsigned short* GB = (unsigned short*)(ws + pg8::XWS_GLU); unsigned short* CX = (unsigned short*)(ws + pg8::XWS_Q); unsigned short* U = (unsigned short*)(ws + pg8::XWS_K);
        float st[8];
#pragma unroll
        for (int k = 0; k < 8; ++k) { const int row = row0 + 32 * (k >> 2) + (k & 3); st[k] = lane < 16 ? stats[(size_t)row * 16 + lane] : 0.f; }
#pragma unroll
        for (int k = 0; k < 8; ++k) { const int row = row0 + 32 * (k >> 2) + (k & 3);
            const float v = s[k >> 2][k & 3] * (1.0f / sqrtf(wsum(st[k]) * (1.0f / 1024.0f) + 1e-6f));
            if (cp < 8) GB[(size_t)row * 512 + 64 * cp + lane] = f2bf16(v);
            else if (cp < 24) { const float p = v * __shfl_xor(v, 32); if (lane < 32) CX[(size_t)row * 512 + 32 * (cp - 8) + lane] = f2bf16(p); }
            else U[(size_t)row * 512 + 64 * (cp - 24) + lane] = f2bf16(v); }
    }
};
#undef TLAS
}

struct Frame {
    LAS unsigned char* lds;
    volatile LAS unsigned* MISC;
    gu32* ctl;
    int wave;
    int vcu, G;
    __device__ __forceinline__ int lane_() const { int l; asm volatile("v_mbcnt_lo_u32_b32 %0, -1, 0\n\tv_mbcnt_hi_u32_b32 %0, -1, %0" : "=v"(l)); return l; }
    __device__ __forceinline__ int tid_() const { return wave * 64 + lane_(); }
};
struct Args { const void* in[25]; float* out; unsigned char* ws; int ph_lo, ph_hi; };
typedef const __attribute__((address_space(4))) Args CArgs;
__device__ __forceinline__ CArgs* argp() { CArgs* p = (CArgs*)__builtin_amdgcn_kernarg_segment_ptr(); asm volatile("" : "+s"(p)); return p; }

__device__ __forceinline__ float wave_sum(float v) {
#pragma unroll
    for (int o = 1; o < 64; o <<= 1) v += __shfl_xor(v, o);
    return v;
}
__device__ __forceinline__ int map_row(int mode, int n) {
    if (mode == 1) {
        if (n < 512) return (n >> 7) * 256 + (n & 127);
        if (n < 1024) { const int m = n - 512; return (m >> 7) * 256 + 128 + (m & 127); }
        return n;
    } else if (mode == 2) {
        if (n < 512) return n;
        if (n < 1024) { const int m = n - 512; return 512 + (m >> 7) * 256 + (m & 127); }
        if (n < 1536) { const int m = n - 1024; return 512 + (m >> 7) * 256 + 128 + (m & 127); }
        return n;
    } else if (mode == 3) {
        if (n < FFN) return (n >> 7) * 256 + (n & 127);
        const int m = n - FFN; return (m >> 7) * 256 + 128 + (m & 127);
    }
    return n;
}
__device__ __forceinline__ void p0_transpose_item(const float* W, int K, int N, bf16* WT, int mode, LAS float* scr, int item, int lane, const float* gk = nullptr) {
    const int nblk = N / 32, kb = item / nblk, nb = item % nblk, k0 = 64 * kb, n0 = 32 * nb;
    const int d0 = map_row(mode, n0);
    float wv[32];
#pragma unroll
    for (int i = 0; i < 32; ++i) wv[i] = __builtin_nontemporal_load(W + (size_t)(k0 + 2 * i + (lane >> 5)) * N + n0 + (lane & 31));
#pragma unroll
    for (int i = 0; i < 32; ++i) scr[(2 * i + (lane >> 5)) * 33 + (lane & 31)] = gk ? wv[i] * gk[k0 + 2 * i + (lane >> 5)] : wv[i];
    LDS_WAIT(); asm volatile("" ::: "memory");
    const int c = lane & 7;
#pragma unroll
    for (int j = 0; j < 4; ++j) { const int n = (lane >> 3) + 8 * j; const LAS float* s = scr + (8 * c) * 33 + n;
        v4u o; o.x = pk2(s[0 * 33], s[1 * 33]); o.y = pk2(s[2 * 33], s[3 * 33]); o.z = pk2(s[4 * 33], s[5 * 33]); o.w = pk2(s[6 * 33], s[7 * 33]);
        *(GAS v4u*)(WT + (size_t)(d0 + n) * K + k0 + 8 * c) = o; }
    LDS_WAIT(); asm volatile("" ::: "memory");
}
__device__ __forceinline__ void p0_fold_item(const float* pw, const float* psc, const float* wo, bf16* WT, int item, int lane) {
    const int g = item >> 8, cb = (item >> 4) & 15, nb = item & 15, n = nb * 64 + lane;
    float acc[8];
#pragma unroll
    for (int i = 0; i < 8; ++i) acc[i] = 0.f;
    const float* pwg = pw + ((size_t)g * 128 + cb * 8) * 128;
#pragma unroll 4
    for (int d = 0; d < 128; ++d) { const float w = wo[(size_t)(512 + g * 128 + d) * DM + n] * psc[g * 128 + d];
#pragma unroll
        for (int i = 0; i < 8; ++i) acc[i] += pwg[i * 128 + d] * w; }
    v4u o; o.x = pk2(acc[0], acc[1]); o.y = pk2(acc[2], acc[3]); o.z = pk2(acc[4], acc[5]); o.w = pk2(acc[6], acc[7]);
    *(GAS v4u*)(WT + (size_t)n * DM + 512 + g * 128 + cb * 8) = o;
}
__device__ __forceinline__ void p0_prologue(Frame& F, CArgs& a) {
    const int lane = F.lane_();
    LAS float* scr = (LAS float*)(F.lds + RING_OFF + F.wave * 16384);
    const int gw = F.vcu * NWAVES + F.wave, NGW = F.G * NWAVES;
    unsigned char* ws = a.ws;
    constexpr int I_IE = 16 * (N_IN_E / 32), I_OUT = 16 * 32, I_IO = 16 * (N_IN_O / 32), I_FI = 16 * (N_FF / 32), I_FO = (FFN / 64) * 32, I_FOLD = 4 * 16 * 16;
    constexpr int NITEMS = I_IE + I_OUT + I_OUT / 2 + I_FOLD + I_IO + 2 * I_FI + 2 * I_FO;
    for (int it = gw; it < NITEMS; it += NGW) {
        int r = it;
        if (r < I_IE) { p0_transpose_item((const float*)a.in[11], DM, N_IN_E, (bf16*)(ws + WS_WE_IN), 1, scr, r, lane, (const float*)a.in[8]); continue; } r -= I_IE;
        if (r < I_OUT) { p0_transpose_item((const float*)a.in[17], DM, DM, (bf16*)(ws + WS_WE_OUT), 0, scr, r, lane); continue; } r -= I_OUT;
        if (r < I_IO) { p0_transpose_item((const float*)a.in[18], DM, N_IN_O, (bf16*)(ws + WS_WO_IN), 2, scr, r, lane, (const float*)a.in[8] + DM); continue; } r -= I_IO;
        if (r < I_OUT / 2) { p0_transpose_item((const float*)a.in[22], DM, DM, (bf16*)(ws + WS_WO_OUT), 0, scr, r, lane); continue; } r -= I_OUT / 2;
        if (r < I_FOLD) { p0_fold_item((const float*)a.in[20], (const float*)a.in[21], (const float*)a.in[22], (bf16*)(ws + WS_WO_OUT), r, lane); continue; } r -= I_FOLD;
        if (r < 2 * I_FI) { const int l = r / I_FI; p0_transpose_item((const float*)a.in[23] + (size_t)l * DM * N_FF, DM, N_FF, (bf16*)(ws + WS_WF_IN + (size_t)l * 11 * MiB), 3, scr, r % I_FI, lane, (const float*)a.in[9] + l * DM); continue; } r -= 2 * I_FI;
        if (r < 2 * I_FO) { const int l = r / I_FO; p0_transpose_item((const float*)a.in[24] + (size_t)l * FFN * DM, FFN, DM, (bf16*)(ws + WS_WF_OUT + (size_t)l * 6 * MiB), 0, scr, r % I_FO, lane); continue; } r -= 2 * I_FO;
    }
    bf16* XN = (bf16*)(ws + WS_XN); float* stats = (float*)(ws + WS_STATS);
    for (int m0 = 2 * gw; m0 < MT; m0 += 2 * NGW) {
        f32x4 v[2][4];
#pragma unroll
        for (int r = 0; r < 2; ++r) { const int m = m0 + r;
            const float* xrow = m < MP ? (const float*)a.in[0] + (size_t)m * DM : (const float*)a.in[1] + (size_t)(m - MP) * DM;
#pragma unroll
            for (int j = 0; j < 4; ++j) v[r][j] = __builtin_nontemporal_load((const f32x4*)xrow + lane + 64 * j); }
#pragma unroll
        for (int r = 0; r < 2; ++r) { const int m = m0 + r; float s = 0.f;
#pragma unroll
            for (int j = 0; j < 4; ++j) s += (v[r][j].x * v[r][j].x + v[r][j].y * v[r][j].y) + (v[r][j].z * v[r][j].z + v[r][j].w * v[r][j].w);
            s = wave_sum(s);
            GAS unsigned long long* o8 = (GAS unsigned long long*)(XN + (size_t)m * DM) + lane;
#pragma unroll
            for (int j = 0; j < 4; ++j) { const f32x4 y = v[r][j]; o8[64 * j] = (unsigned long long)pk2(y.x, y.y) | ((unsigned long long)pk2(y.z, y.w) << 32); }
            if (lane < 16) stats[(size_t)m * 16 + lane] = lane == 0 ? s : 0.f; }
    }
}

__device__ __forceinline__ void conv_phase(Frame& F, CArgs& a) {
    const int lane = F.lane_(); const int tid = F.wave * 64 + lane, half = tid >> 8, cp = tid & 255, c0 = 2 * cp;
    const float* cw = (const float*)a.in[12]; const float* st = (const float*)a.in[4];
    const bf16* GLU = (const bf16*)(a.ws + WS_GLU); bf16* AB = (bf16*)(a.ws + WS_AB);
    float* conv_p = a.out + O_CONVP; float* conv_s = a.out + O_CONVS;
    f32x2 wv[CW];
#pragma unroll
    for (int t = 0; t < CW; ++t) wv[t] = *(const f32x2*)(cw + t * 512 + c0);
    const f32x2 cb = *(const f32x2*)((const float*)a.in[13] + c0), lg = *(const f32x2*)((const float*)a.in[14] + c0), lb = *(const f32x2*)((const float*)a.in[15] + c0);
    LAS float* red = (LAS float*)(F.lds + RING_OFF);
    int it_par = 0;
#define SLOT(i) (i)
    unsigned raw[38];
#define CONV_FETCH(gg) do { const int seq_ = (gg) >> 8, t0_ = ((gg) & 255) * 8; _Pragma("unroll") for (int i = 0; i < 38; ++i) { const int t = t0_ - 30 + i; \
        raw[i] = *(const unsigned*)(GLU + (size_t)(seq_ * SEQ + (t < 0 ? 0 : t)) * 512 + c0); } } while (0)
    { const int g0 = 2 * F.vcu + half; if (g0 < MP / 8) CONV_FETCH(g0); }
    for (int pair = F.vcu; pair < (MT / 8) / 2; pair += F.G) {
        const int g = 2 * pair + half;
        f32x2 xv[38]; int row0;
        if (g < MP / 8) {
            const int seq = g >> 8, t0 = (g & 255) * 8; row0 = seq * SEQ + t0;
#pragma unroll
            for (int i = 0; i < 38; ++i) { const unsigned v = (t0 - 30 + i) < 0 ? 0u : raw[i]; xv[i] = (f32x2){bflo(v), bfhi(v)}; }
            { const int gn = g + 2 * F.G; if (pair + F.G < (MT / 8) / 2 && gn < MP / 8) CONV_FETCH(gn); }
#pragma unroll
            for (int j = 0; j < 8; ++j) { const int t = t0 + j; if (t >= SEQ - 30) *(f32x2*)(conv_p + ((size_t)seq * 30 + (t - (SEQ - 30))) * 512 + c0) = xv[30 + j]; }
        } else {
            const int b = g - MP / 8; row0 = MP + b * 8;
#pragma unroll
            for (int i = 0; i < 30; ++i) xv[i] = *(const f32x2*)(st + ((size_t)b * 30 + i) * 512 + c0);
#pragma unroll
            for (int i = 30; i < 38; ++i) { const unsigned v = *(const unsigned*)(GLU + (size_t)(row0 + i - 30) * 512 + c0); xv[i] = (f32x2){bflo(v), bfhi(v)}; }
#pragma unroll
            for (int i = 8; i < 38; ++i) *(f32x2*)(conv_s + ((size_t)b * 30 + (i - 8)) * 512 + c0) = xv[i];
        }
        float a0[8], a1[8], sv[16];
#pragma unroll
        for (int j = 0; j < 8; ++j) { f32x2 s = cb;
#pragma unroll
            for (int t = 0; t < CW; ++t) s = __builtin_elementwise_fma(wv[t], xv[j + t], s);
            a0[j] = s.x; a1[j] = s.y; sv[2 * j] = s.x + s.y; sv[2 * j + 1] = s.x * s.x + s.y * s.y; }
#pragma unroll
        for (int k = 0; k < 8; ++k) { const bool up = (lane & 1) != 0; const float mine = up ? sv[2 * k + 1] : sv[2 * k], other = up ? sv[2 * k] : sv[2 * k + 1]; sv[k] = mine + __shfl_xor(other, 1); }
#pragma unroll
        for (int k = 0; k < 4; ++k) { const bool up = (lane & 2) != 0; const float mine = up ? sv[2 * k + 1] : sv[2 * k], other = up ? sv[2 * k] : sv[2 * k + 1]; sv[k] = mine + __shfl_xor(other, 2); }
#pragma unroll
        for (int k = 0; k < 2; ++k) { const bool up = (lane & 4) != 0; const float mine = up ? sv[2 * k + 1] : sv[2 * k], other = up ? sv[2 * k] : sv[2 * k + 1]; sv[k] = mine + __shfl_xor(other, 4); }
        { const bool up = (lane & 8) != 0; const float mine = up ? sv[1] : sv[0], other = up ? sv[0] : sv[1]; sv[0] = mine + __shfl_xor(other, 8); }
        float tot = sv[0]; tot += __shfl_xor(tot, 16); tot += __shfl_xor(tot, 32);
        LAS float* redb = red + (it_par & 1) * 128;
        if (lane < 16) redb[(half * 4 + (F.wave & 3)) * 16 + lane] = tot;
        __syncthreads();
#pragma unroll
        for (int j = 0; j < 8; ++j) {
            float s = 0.f, q = 0.f;
#pragma unroll
            for (int w = 0; w < 4; ++w) { s += redb[(half * 4 + w) * 16 + SLOT(2 * j)]; q += redb[(half * 4 + w) * 16 + SLOT(2 * j + 1)]; }
            const float mu = s * (1.f / 512.f), var = fmaxf(q * (1.f / 512.f) - mu * mu, 0.f), rstd = 1.0f / sqrtf(var + EPS);
            const float y0 = (a0[j] - mu) * rstd * lg.x + lb.x, y1 = (a1[j] - mu) * rstd * lg.y + lb.y;
            *(unsigned*)(AB + (size_t)(row0 + j) * DM + c0) = pk2(y0 * sigm(y0), y1 * sigm(y1));
        }
        ++it_par;
    }
#undef SLOT
#undef CONV_FETCH
}

constexpr int ATT_P_LDS = sba::P4_BYTES;
static_assert(ATT_P_LDS + sbs::L_SOLO_BYTES <= RING_BYTES, "attention LDS map");
__device__ __forceinline__ void attn_dual_phase(Frame& F) {
    if (F.tid_() == 0) *(LAS unsigned*)(F.lds + RING_OFF + sba::P4_BAR) = 0u;
    __syncthreads();
    if (F.wave < 4) {
        CArgs& a = *argp();
        const unsigned short* Q = (const unsigned short*)(a.ws + WS_Q); const unsigned short* Kb = (const unsigned short*)(a.ws + WS_K); const unsigned short* Vb = (const unsigned short*)(a.ws + WS_V);
        unsigned btarget = 0u;
        unsigned short* O = (unsigned short*)(a.ws + WS_AB) + 512;
        for (int p = F.vcu; p < NB * NH * 8; p += F.G) {
            const int bh = p >> 3, s = p & 7, b = bh >> 3, h = bh & 7;
            const float bias2 = ((const float*)a.in[16])[h] * LOG2E;
#pragma nounroll
            for (int k = 0; k < 2; ++k) sba::unitP4(b, h, k ? 15 - s : s, Q, Kb, Vb, O, bias2, F.lds + RING_OFF, F.wave, btarget);
        }
    } else {
        CArgs& a = *argp();
        for (int p = F.vcu; p < NDB * 2; p += F.G)
            sbs::unit<true>(p >> 1, p & 1, (const unsigned short*)(a.ws + WS_Q), (const unsigned short*)(a.ws + WS_K), (const unsigned short*)(a.ws + WS_V), (const float*)a.in[2], (const float*)a.in[3], (const int*)a.in[7], (const float*)a.in[16],
                            (unsigned short*)(a.ws + WS_AB), F.lds + RING_OFF + ATT_P_LDS, F.wave - 4);
    }
    __syncthreads();
}
template <int W> __device__ __forceinline__ void pool8(const float (&e0)[23], const float (&e1)[23], bf16* CDrow0, bool prompt, int ts) {
#pragma unroll
    for (int j = 0; j < 8; ++j) { float s0 = 0.f, s1 = 0.f;
#pragma unroll
        for (int i = 0; i < W; ++i) { s0 += e0[15 + j - i]; s1 += e1[15 + j - i]; }
        int cnt = W; if (prompt && ts + j + 1 < W) cnt = ts + j + 1;
        const float inv = 1.0f / (float)cnt;
        *(unsigned*)(CDrow0 + (size_t)j * DM) = pk2(s0 * inv - e0[15 + j], s1 * inv - e1[15 + j]); }
}
__device__ __forceinline__ void mix_odd_phase(Frame& F, CArgs& a) {
    const int tid = F.tid_(), half = tid >> 8, cp = tid & 255, c0 = 2 * cp, gi = c0 >> 7;
    const bf16* GB = (const bf16*)(a.ws + WS_GB); const bf16* CX = (const bf16*)(a.ws + WS_CX); const bf16* U = (const bf16*)(a.ws + WS_U); bf16* CD = (bf16*)(a.ws + WS_CDD);
    const float* st_sc = (const float*)a.in[5]; const float* st_pl = (const float*)a.in[6]; const float* ccw = (const float*)a.in[19];
    float* sc_p = a.out + O_SCP; float* sc_s = a.out + O_SCS; float* pool_p = a.out + O_POOLP; float* pool_s = a.out + O_POOLS;
    const f32x2 cw0 = *(const f32x2*)(ccw + c0), cw1 = *(const f32x2*)(ccw + 512 + c0), cw2 = *(const f32x2*)(ccw + 1024 + c0);
    for (int pair = F.vcu; pair < (MT / 8) / 2; pair += F.G) {
        const int g = 2 * pair + half; const bool prompt = g < MP / 8;
        int rowbase, ts, b = 0, seq = 0;
        if (prompt) { seq = g >> 8; ts = (g & 255) * 8; rowbase = seq * SEQ; } else { b = g - MP / 8; rowbase = MP + b * 8; ts = 0; }
        float e0[23], e1[23], x0[10], x1[10];
        if (prompt) {
#pragma unroll
            for (int i = 0; i < 23; ++i) { const int t = ts - 15 + i; unsigned w = __builtin_nontemporal_load((const unsigned*)(U + (size_t)(rowbase + (t < 0 ? 0 : t)) * 512 + c0)); w = t < 0 ? 0u : w; e0[i] = bflo(w); e1[i] = bfhi(w); }
#pragma unroll
            for (int i = 0; i < 10; ++i) { const int t = ts - 2 + i; unsigned w = __builtin_nontemporal_load((const unsigned*)(CX + (size_t)(rowbase + (t < 0 ? 0 : t)) * 512 + c0)); w = t < 0 ? 0u : w; x0[i] = bflo(w); x1[i] = bfhi(w); }
        } else {
#pragma unroll
            for (int i = 0; i < 15; ++i) { const f32x2 w = *(const f32x2*)(st_pl + ((size_t)b * 15 + i) * 512 + c0); e0[i] = w.x; e1[i] = w.y; }
#pragma unroll
            for (int i = 15; i < 23; ++i) { const unsigned w = *(const unsigned*)(U + (size_t)(rowbase + i - 15) * 512 + c0); e0[i] = bflo(w); e1[i] = bfhi(w); }
#pragma unroll
            for (int i = 0; i < 2; ++i) { const f32x2 w = *(const f32x2*)(st_sc + ((size_t)b * 2 + i) * 512 + c0); x0[i] = w.x; x1[i] = w.y; }
#pragma unroll
            for (int i = 2; i < 10; ++i) { const unsigned w = *(const unsigned*)(CX + (size_t)(rowbase + i - 2) * 512 + c0); x0[i] = bflo(w); x1[i] = bfhi(w); }
        }
        bf16* CDr = CD + (size_t)(rowbase + ts) * DM;
        unsigned gw[8];
#pragma unroll
        for (int j = 0; j < 8; ++j) gw[j] = __builtin_nontemporal_load((const unsigned*)(GB + (size_t)(rowbase + ts + j) * 512 + c0));
#pragma unroll
        for (int j = 0; j < 8; ++j)
            *(unsigned*)(CDr + (size_t)j * DM + c0) = pk2(bflo(gw[j]) * (cw0.x * x0[j] + cw1.x * x0[j + 1] + cw2.x * x0[j + 2]), bfhi(gw[j]) * (cw0.y * x1[j] + cw1.y * x1[j + 1] + cw2.y * x1[j + 2]));
        bf16* CDp = CDr + 512 + c0;
        if (gi == 0) pool8<2>(e0, e1, CDp, prompt, ts); else if (gi == 1) pool8<4>(e0, e1, CDp, prompt, ts); else if (gi == 2) pool8<8>(e0, e1, CDp, prompt, ts); else pool8<16>(e0, e1, CDp, prompt, ts);
        if (prompt) {
            if (ts + 7 >= SEQ - 15) {
#pragma unroll
                for (int j = 0; j < 8; ++j) { const int t = ts + j;
                    if (t >= SEQ - 15) *(f32x2*)(pool_p + ((size_t)seq * 15 + t - (SEQ - 15)) * 512 + c0) = (f32x2){e0[15 + j], e1[15 + j]};
                    if (t >= SEQ - 2) *(f32x2*)(sc_p + ((size_t)seq * 2 + t - (SEQ - 2)) * 512 + c0) = (f32x2){x0[2 + j], x1[2 + j]}; } }
        } else {
#pragma unroll
            for (int i = 0; i < 15; ++i) *(f32x2*)(pool_s + ((size_t)b * 15 + i) * 512 + c0) = (f32x2){e0[8 + i], e1[8 + i]};
            *(f32x2*)(sc_s + ((size_t)b * 2 + 0) * 512 + c0) = (f32x2){x0[8], x1[8]}; *(f32x2*)(sc_s + ((size_t)b * 2 + 1) * 512 + c0) = (f32x2){x0[9], x1[9]};
        }
    }
}
__device__ __forceinline__ void final_norm_phase(Frame& F, CArgs& a) {
    const int lane = F.lane_();
    const int gw = F.vcu * NWAVES + F.wave, NGW = F.G * NWAVES;
    const float* gf = (const float*)a.in[10]; const float* stats = (const float*)(a.ws + WS_STATS);
    const bf16* HI = (const bf16*)(a.ws + WS_XN);
    f32x4 gv[4];
#pragma unroll
    for (int j = 0; j < 4; ++j) gv[j] = *((const f32x4*)gf + lane + 64 * j);
    for (int m0 = gw; m0 < MT; m0 += 3 * NGW) {
        v2u h[3][4]; float s[3];
#pragma unroll
        for (int u = 0; u < 3; ++u) { const int m = (m0 + u * NGW) < MT ? (m0 + u * NGW) : m0;
            s[u] = stats[(size_t)m * 16 + (lane & 15)];
            const v2u* hr = (const v2u*)(HI + (size_t)m * DM) + lane;
#pragma unroll
            for (int j = 0; j < 4; ++j) h[u][j] = __builtin_nontemporal_load(hr + 64 * j); }
#pragma unroll
        for (int u = 0; u < 3; ++u) { const int m = m0 + u * NGW;
            float t = s[u]; t += __shfl_xor(t, 1); t += __shfl_xor(t, 2); t += __shfl_xor(t, 4); t += __shfl_xor(t, 8);
            const float r = 1.0f / sqrtf(t * (1.f / 1024.f) + EPS);
            if (m < MT) { f32x4* yr = (f32x4*)(a.out + (size_t)m * DM) + lane;
#pragma unroll
                for (int j = 0; j < 4; ++j) { const f32x4 x = {bflo(h[u][j].x), bfhi(h[u][j].x), bflo(h[u][j].y), bfhi(h[u][j].y)}; yr[64 * j] = x * r * gv[j]; } } }
    }
}

#ifndef MK_PER_PHASE
#define MK_PER_PHASE 0
#endif
constexpr int N_PHASES = 12;
__global__ void __launch_bounds__(NWAVES * 64, 2) mk_fwd(Args args) {
    extern __shared__ __attribute__((aligned(16))) unsigned char lds[];
    Frame F;
    F.lds = (LAS unsigned char*)lds;
    F.MISC = (volatile LAS unsigned*)(F.lds + MISC_OFF);
    F.wave = __builtin_amdgcn_readfirstlane((int)threadIdx.x >> 6);
    F.G = gridDim.x; { const int bx = blockIdx.x; F.vcu = (F.G % 8 == 0) ? (bx % 8) * (F.G / 8) + bx / 8 : bx; }
#define ARGP() argp()
    F.ctl = (gu32*)(ARGP()->ws + WS_CTL);
    for (int u = F.tid_(); u < (LDS_BYTES - LDSCTL_OFF) / 4; u += NWAVES * 64) ((LAS unsigned*)(F.lds + LDSCTL_OFF))[u] = 0u;
    __syncthreads();
    XcdBarrier bar; bar.bar = (unsigned*)(F.ctl + CW_BAR); bar.x = 0; bar.st = nullptr; bar.wv = F.wave;
    if (!MK_PER_PHASE) bar = xcd_barrier_post((unsigned*)(F.ctl + CW_BAR), F.MISC + 8, F.wave);
    const int lo = ARGP()->ph_lo, hi = ARGP()->ph_hi;
#define IN(k) (lo <= (k) && (k) < hi)
#define SEAM(k) do { if (IN(k) && IN((k) + 1)) xcd_barrier(bar); } while (0)
#define TAIL_PHASE(EPI, Aoff, Boff, KK, NCP, ...) do { CArgs* A_ = ARGP(); unsigned char* ws = A_->ws; (void)ws; static_assert(tg::L_BYTES <= RING_BYTES, "tail LDS"); \
        tg::EPI E{__VA_ARGS__}; tg::tail_gemm<tg::EPI>(F.lds + RING_OFF, (const unsigned short*)(ws + (Aoff)), (const unsigned short*)(ws + (Boff)), (KK), (NCP), E, F.wave, F.vcu, F.G); } while (0)
#define GEMM_PHASE(EPI, MM, Aoff, Boff, NN, KK, ...) do { CArgs* A_ = ARGP(); unsigned char* ws = A_->ws; (void)ws; \
        pg8::Gemm g{(const bf16*)(ws + (Aoff)), (const bf16*)(ws + (Boff)), (MM), (NN), (KK)}; pg8::StaticOrder S; S.init((MM), (NN), F.G, (int)blockIdx.x); \
        pg8::EPI E{__VA_ARGS__}; if constexpr (pg8::EPI::ROWSCALE) pg8::prefetch_rowscale(F.lds + RING_OFF, (const float*)(ws + WS_STATS), S, F.tid_(), F.wave); \
        pg8::gemm_phase<pg8::EPI, pg8::StaticOrder, true, true>(F.lds + RING_OFF, g, S, E, F.wave); } while (0)

    if (IN(0)) {
#ifndef NO_P0
        p0_prologue(F, *ARGP());
#endif
    } SEAM(0);
    if (IN(1)) GEMM_PHASE(EpiInEven, MT, WS_XN, WS_WE_IN, N_IN_E, DM, ws, A_->out, F.lds + RING_OFF); SEAM(1);
    if (IN(2)) {
#ifndef NO_CONV
        conv_phase(F, *ARGP());
        __syncthreads();
#endif
#ifndef NO_ATTN
        attn_dual_phase(F);
#endif
    } SEAM(2);
    if (IN(3)) { GEMM_PHASE(EpiResM, MP, WS_AB, WS_WE_OUT, DM, DM, ws, (const float*)nullptr, (const float*)nullptr);
        TAIL_PHASE(TailResM, WS_AB, WS_WE_OUT, DM, 16, ws, (const float*)nullptr); } SEAM(3);
    if (IN(4)) GEMM_PHASE(EpiFfn, MT, WS_XN, WS_WF_IN, N_FF, DM, ws, F.lds + RING_OFF); SEAM(4);
    if (IN(5)) { GEMM_PHASE(EpiResM, MP, WS_ACT, WS_WF_OUT, DM, FFN, ws, (const float*)nullptr, (const float*)nullptr);
        TAIL_PHASE(TailResM, WS_ACT, WS_WF_OUT, FFN, 16, ws, (const float*)nullptr); } SEAM(5);
    if (IN(6)) { GEMM_PHASE(EpiInOdd, MP, WS_XN, WS_WO_IN, N_IN_O, DM, ws, F.lds + RING_OFF);
        TAIL_PHASE(TailInOdd, WS_XN, WS_WO_IN, DM, 32, ws); } SEAM(6);
    if (IN(7)) {
#ifndef NO_ODD
        mix_odd_phase(F, *ARGP());
#endif
    } SEAM(7);
    if (IN(8)) { GEMM_PHASE(EpiResM, MP, WS_CDD, WS_WO_OUT, DM, DM, ws, (const float*)nullptr, (const float*)nullptr);
        TAIL_PHASE(TailResM, WS_CDD, WS_WO_OUT, DM, 16, ws, (const float*)nullptr); } SEAM(8);
    if (IN(9)) GEMM_PHASE(EpiFfn, MT, WS_XN, WS_WF_IN + 11 * MiB, N_FF, DM, ws, F.lds + RING_OFF); SEAM(9);
    if (IN(10)) { GEMM_PHASE(EpiResM, MP, WS_ACT, WS_WF_OUT + 6 * MiB, DM, FFN, ws, (const float*)nullptr, (const float*)nullptr);
        TAIL_PHASE(TailResM, WS_ACT, WS_WF_OUT + 6 * MiB, FFN, 16, ws, (const float*)nullptr); } SEAM(10);
    if (IN(11)) final_norm_phase(F, *ARGP());


#undef IN
#undef SEAM
#undef GEMM_PHASE
#undef TAIL_PHASE
#undef ARGP
}

extern "C" void kernel_launch(void* const* d_in, const int* in_sizes, int n_in, void* d_out, int out_size, void* d_ws, size_t ws_size, hipStream_t stream) {
    static int grid = 0;
    if (grid == 0) {
        if (n_in != 25 || out_size != (int)O_END || ws_size < WS_END) { fprintf(stderr, "kernel_launch: unexpected shapes (n_in %d, out %d, ws %zu); nothing launched\n", n_in, out_size, ws_size); grid = -1; return; }
        int dev = 0, cus = 0, per_cu = 0;
        if (hipGetDevice(&dev) != hipSuccess || hipDeviceGetAttribute(&cus, hipDeviceAttributeMultiprocessorCount, dev) != hipSuccess) { grid = -1; return; }
        if (hipFuncSetAttribute((const void*)mk_fwd, hipFuncAttributeMaxDynamicSharedMemorySize, LDS_BYTES) != hipSuccess) { fprintf(stderr, "kernel_launch: hipFuncSetAttribute failed\n"); grid = -1; return; }
        if (hipOccupancyMaxActiveBlocksPerMultiprocessor(&per_cu, (const void*)mk_fwd, NWAVES * 64, LDS_BYTES) != hipSuccess || per_cu < 1) { fprintf(stderr, "kernel_launch: occupancy query reports %d workgroups per CU\n", per_cu); }
        (void)hipGetLastError();
        grid = cus;
    }
    if (grid < 0) return;
    if (hipMemsetAsync((char*)d_ws + WS_CTL, 0, CTL_ZERO_BYTES, stream) != hipSuccess) return;
    Args a{};
    for (int i = 0; i < 25; ++i) a.in[i] = d_in[i];
    a.out = (float*)d_out; a.ws = (unsigned char*)d_ws;
#if MK_PER_PHASE
    for (int p = 0; p < N_PHASES; ++p) { a.ph_lo = p; a.ph_hi = p + 1; hipLaunchKernelGGL(mk_fwd, dim3(grid), dim3(NWAVES * 64), LDS_BYTES, stream, a); }
#else
    a.ph_lo = 0; a.ph_hi = N_PHASES;
    hipLaunchKernelGGL(mk_fwd, dim3(grid), dim3(NWAVES * 64), LDS_BYTES, stream, a);
#endif
}
```

```cpp
#include <hip/hip_runtime.h>
#include <cstdio>
#include <cstdint>

namespace pg8 {
#define PG8_LAS __attribute__((address_space(3)))
typedef unsigned short bf16_t;
typedef short bf16x8 __attribute__((ext_vector_type(8)));
typedef float f32x4 __attribute__((ext_vector_type(4)));
typedef unsigned u32x4 __attribute__((ext_vector_type(4)));
constexpr int BM = 256, BK = 64, HALF = 128, HTB = HALF * BK * 2  , STAGE_BYTES = 8 * HTB, NXCD = 8, WGM = 8;

__host__ __device__ __forceinline__ int lds_byte(int r, int c) { const int st = (r >> 4) * 2 + (c >> 5), rr = r & 15, cc = c & 31, ob = rr * 64 + cc * 2; return st * 1024 + (ob ^ (((ob >> 9) & 1) << 5)); }
__host__ __device__ __forceinline__ void stage_rc(int b, int& R, int& C) { const int st = b / 1024, sb = b % 1024, swz = sb ^ (((sb >> 9) & 1) << 5); R = (st >> 1) * 16 + swz / 64; C = (st & 1) * 32 + (swz % 64) / 2; }
__host__ __device__ __forceinline__ int perm32(int rho) { const int n = rho >> 4, i = rho & 15; return 8 * (i >> 2) + 4 * n + (i & 3); }

struct Unit { int pm, pn, i; };
struct Gemm { const bf16_t* A; const bf16_t* Bt; int M, N, K; };

struct StaticOrder {
    int nM, nN, nwg, G, c;
    __host__ __device__ void init(int M, int N, int G_, int c_) { nM = M / BM; nN = N / BM; nwg = nM * nN; G = G_; c = c_; }
    __host__ __device__ bool next(int i, Unit& u) const {
        const long L = (long)i * G + c; if (L >= nwg) return false;
        int wgid = (int)L; { const int q = nwg / NXCD, r = nwg % NXCD, xcd = wgid % NXCD, off = wgid / NXCD; wgid = (xcd < r ? xcd * (q + 1) : r * (q + 1) + (xcd - r) * q) + off; }
        const int nig = WGM * nN, gid = wgid / nig, fm = gid * WGM, gsz = (nM - fm) < WGM ? (nM - fm) : WGM;
        u.pm = fm + ((wgid % nig) % gsz); u.pn = (wgid % nig) / gsz; u.i = i; return true;
    }
    __device__ __forceinline__ void a_ready(const Unit&) const {}
    __device__ __forceinline__ void done(const Unit&) const {}
};

__device__ __forceinline__ unsigned cvt_pk_bf16(float lo, float hi) { unsigned r; asm volatile("v_cvt_pk_bf16_f32 %0, %1, %2" : "=v"(r) : "v"(lo), "v"(hi)); return r; }
typedef float f32x2 __attribute__((ext_vector_type(2)));
typedef unsigned u32x4e __attribute__((ext_vector_type(4)));
constexpr int NROWS_P = 16384;
constexpr float RMS_EPS = 1e-6f;
constexpr size_t XMiB = 1u << 20, XWS_STATS = 50 * XMiB, XWS_XN = 52 * XMiB, XWS_GLU = 86 * XMiB, XWS_Q = 103 * XMiB, XWS_K = 120 * XMiB, XWS_V = 137 * XMiB, XWS_AB = 154 * XMiB, XWS_ACT = 188 * XMiB, XWS_LO = 282 * XMiB;
constexpr size_t XO_KP = (size_t)17408 * 1024, XO_VP = XO_KP + (size_t)16384 * 512, XO_KS = XO_VP + (size_t)16384 * 512, XO_VS = XO_KS + (size_t)1024 * 512;
constexpr float XQSCALE = 0.125f * 1.4426950408889634f;
constexpr int RS_OFF = 131072, RS_SLOTS = 8;
template <class Sched> __device__ __forceinline__ void prefetch_rowscale(PG8_LAS unsigned char* lds, const float* stats, const Sched& S, int tid, int wid) {
    PG8_LAS float* T = (PG8_LAS float*)(lds + RS_OFF);
    const int r = tid & 255, sh = wid >> 2;
    f32x4 v[4][4]; bool ok[4];
#pragma unroll
    for (int j = 0; j < 4; ++j) { Unit u{0, 0, 0}; ok[j] = S.next(2 * j + sh, u); const int pm = ok[j] ? u.pm : 0;
        const f32x4* p = (const f32x4*)(stats + (size_t)(pm * BM + r) * 16);
        v[j][0] = p[0]; v[j][1] = p[1]; v[j][2] = p[2]; v[j][3] = p[3]; }
#pragma unroll
    for (int j = 0; j < 4; ++j) { const f32x4 a = v[j][0], b = v[j][1], c = v[j][2], d = v[j][3];
        const float s = ((a[0] + a[1]) + (a[2] + a[3])) + ((b[0] + b[1]) + (b[2] + b[3])) + ((c[0] + c[1]) + (c[2] + c[3])) + ((d[0] + d[1]) + (d[2] + d[3]));
        if (ok[j]) T[(2 * j + sh) * 256 + r] = 1.0f / sqrtf(s * (1.0f / 1024.0f) + RMS_EPS); }
    __syncthreads();
}
__device__ __forceinline__ void load_rowscale(float (&rs)[2][4], PG8_LAS const unsigned char* lds, const Unit& u, int wr, int fr) {
    const PG8_LAS float* T = (const PG8_LAS float*)(lds + RS_OFF) + (u.i & (RS_SLOTS - 1)) * 256;
#pragma unroll
    for (int ai = 0; ai < 2; ++ai)
#pragma unroll
        for (int m = 0; m < 4; ++m) rs[ai][m] = T[ai * HALF + wr * 64 + m * 16 + fr];
}
__device__ __forceinline__ float sigmoidf_(float x) { return __builtin_amdgcn_rcpf(1.0f + __builtin_amdgcn_exp2f(-1.4426950408889634f * x)); }
__device__ __forceinline__ f32x4 sigmoid4(const f32x4 x) { const f32x4 t = x * -1.4426950408889634f; const f32x4 e = {__builtin_amdgcn_exp2f(t[0]), __builtin_amdgcn_exp2f(t[1]), __builtin_amdgcn_exp2f(t[2]), __builtin_amdgcn_exp2f(t[3])};
    const f32x4 d = e + 1.0f; return (f32x4){__builtin_amdgcn_rcpf(d[0]), __builtin_amdgcn_rcpf(d[1]), __builtin_amdgcn_rcpf(d[2]), __builtin_amdgcn_rcpf(d[3])}; }
__device__ __forceinline__ u32x4e pack8(const f32x4 a, const f32x4 b) { u32x4e w; w.x = cvt_pk_bf16(a[0], a[1]); w.y = cvt_pk_bf16(a[2], a[3]); w.z = cvt_pk_bf16(b[0], b[1]); w.w = cvt_pk_bf16(b[2], b[3]); return w; }

struct EpiInEven {
    static constexpr bool PERM = true, AFTER_DRAIN = false, INIT_ACC = false, ROWSCALE = true;
    unsigned char* ws; float* out; PG8_LAS unsigned char* lds;
    __device__ __forceinline__ void operator()(const f32x4 (&acc)[2][2][4][2], const Unit& u, int wr, int wc, int fr, int fq) const {
        const float* stats = (const float*)(ws + XWS_STATS); bf16_t* GLU = (bf16_t*)(ws + XWS_GLU); bf16_t* Q = (bf16_t*)(ws + XWS_Q); bf16_t* Kb = (bf16_t*)(ws + XWS_K); bf16_t* Vb = (bf16_t*)(ws + XWS_V);
        float* kp = out + XO_KP; float* vp = out + XO_VP; float* ks = out + XO_KS; float* vs = out + XO_VS; const float qscale = XQSCALE;
        float rs[2][4]; load_rowscale(rs, lds, u, wr, fr);
        const int pn = u.pn;
        if (pn < 4) {
#pragma unroll
            for (int ai = 0; ai < 2; ++ai)
#pragma unroll
                for (int m = 0; m < 4; ++m) { const int row = u.pm * BM + ai * HALF + wr * 64 + m * 16 + fr; const float r = rs[ai][m];
                    f32x4 o[2];
#pragma unroll
                    for (int n = 0; n < 2; ++n) { const f32x4 val = acc[ai][0][m][n] * r, gate = acc[ai][1][m][n] * r; o[n] = val * sigmoid4(gate); }
                    *(u32x4e*)(GLU + (size_t)row * 512 + pn * 128 + wc * 32 + 8 * fq) = pack8(o[0], o[1]); }
        } else {
            const int t = (pn - 4) >> 1, colt = ((pn - 4) & 1) * 256;
#pragma unroll
            for (int ai = 0; ai < 2; ++ai)
#pragma unroll
                for (int m = 0; m < 4; ++m) { const int row = u.pm * BM + ai * HALF + wr * 64 + m * 16 + fr; const float r = rs[ai][m];
#pragma unroll
                    for (int bj = 0; bj < 2; ++bj) { const int col = colt + bj * HALF + wc * 32 + 8 * fq;
                        f32x4 v0 = acc[ai][bj][m][0] * r, v1 = acc[ai][bj][m][1] * r;
                        if (t == 0) { v0 = v0 * qscale; v1 = v1 * qscale; *(u32x4e*)(Q + (size_t)row * 512 + col) = pack8(v0, v1); }
                        else { float* fo; bf16_t* bo;
                            if (t == 1) { fo = row < NROWS_P ? kp + (size_t)row * 512 : ks + (size_t)(row - NROWS_P) * 512; bo = Kb; }
                            else        { fo = row < NROWS_P ? vp + (size_t)row * 512 : vs + (size_t)(row - NROWS_P) * 512; bo = Vb; }
                            *(f32x4*)(fo + col) = v0; *(f32x4*)(fo + col + 4) = v1; *(u32x4e*)(bo + (size_t)row * 512 + col) = pack8(v0, v1); } } }
        }
    }
};
struct EpiInOdd {
    static constexpr bool PERM = true, AFTER_DRAIN = false, INIT_ACC = false, ROWSCALE = true;
    unsigned char* ws; PG8_LAS unsigned char* lds;
    static __device__ __forceinline__ int lane_now() { int l; asm volatile("v_mbcnt_lo_u32_b32 %0, -1, 0\n\tv_mbcnt_hi_u32_b32 %0, -1, %0" : "=v"(l)); return l; }
    __device__ __forceinline__ void pre_slab(const Unit& u, int wr, int wc, int, int) const {
        const float* stats = (const float*)(ws + XWS_STATS); const int ln = lane_now();
        const f32x4* p = (const f32x4*)(stats + (size_t)(NROWS_P + 16 * u.pm + (ln & 15)) * 16);
        const f32x4 a = p[0], b = p[1], c = p[2], d = p[3];
        const float s = ((a[0] + a[1]) + (a[2] + a[3])) + ((b[0] + b[1]) + (b[2] + b[3])) + ((c[0] + c[1]) + (c[2] + c[3])) + ((d[0] + d[1]) + (d[2] + d[3]));
        ((PG8_LAS float*)(lds + RS_OFF + 2048))[(wr * 4 + wc) * 64 + ln] = 1.0f / sqrtf(s * (1.0f / 1024.0f) + RMS_EPS);
    }
    __device__ __forceinline__ void slab_out(const f32x4 (&s)[2], const Unit& u, int wr, int wc, int fr, int fq) const {
        const float r = ((const PG8_LAS float*)(lds + RS_OFF + 2048))[(wr * 4 + wc) * 64 + lane_now()];
        bf16_t* GB = (bf16_t*)(ws + XWS_GLU); bf16_t* CX = (bf16_t*)(ws + XWS_Q); bf16_t* U = (bf16_t*)(ws + XWS_K);
        const size_t row = (size_t)(NROWS_P + 16 * u.pm + fr); const int cw = wc * 32 + 8 * fq + 4 * wr, pn = u.pn;
        if (pn >= 2 && pn < 6) { const f32x4 o = s[0] * s[1] * (r * r); f32x2 w; w.x = __builtin_bit_cast(float, cvt_pk_bf16(o[0], o[1])); w.y = __builtin_bit_cast(float, cvt_pk_bf16(o[2], o[3]));
            *(f32x2*)(CX + row * 512 + (pn - 2) * 128 + cw) = w; }
        else { bf16_t* O = pn < 2 ? GB : U; const int colt = (pn & 1) * 256;
#pragma unroll
            for (int bj = 0; bj < 2; ++bj) { const f32x4 o = s[bj] * r; f32x2 w; w.x = __builtin_bit_cast(float, cvt_pk_bf16(o[0], o[1])); w.y = __builtin_bit_cast(float, cvt_pk_bf16(o[2], o[3]));
                *(f32x2*)(O + row * 512 + colt + bj * HALF + cw) = w; } }
    }
    __device__ __forceinline__ void operator()(const f32x4 (&acc)[2][2][4][2], const Unit& u, int wr, int wc, int fr, int fq) const {
        const float* stats = (const float*)(ws + XWS_STATS); bf16_t* GB = (bf16_t*)(ws + XWS_GLU); bf16_t* CX = (bf16_t*)(ws + XWS_Q); bf16_t* U = (bf16_t*)(ws + XWS_K);
        float rs[2][4]; load_rowscale(rs, lds, u, wr, fr);
        const int pn = u.pn;
        if (pn >= 2 && pn < 6) {
#pragma unroll
            for (int ai = 0; ai < 2; ++ai)
#pragma unroll
                for (int m = 0; m < 4; ++m) { const int row = u.pm * BM + ai * HALF + wr * 64 + m * 16 + fr; const float r2 = rs[ai][m] * rs[ai][m];
                    const f32x4 o0 = acc[ai][0][m][0] * acc[ai][1][m][0] * r2, o1 = acc[ai][0][m][1] * acc[ai][1][m][1] * r2;
                    *(u32x4e*)(CX + (size_t)row * 512 + (pn - 2) * 128 + wc * 32 + 8 * fq) = pack8(o0, o1); }
        } else {
            bf16_t* O = pn < 2 ? GB : U; const int colt = (pn & 1) * 256;
#pragma unroll
            for (int ai = 0; ai < 2; ++ai)
#pragma unroll
                for (int m = 0; m < 4; ++m) { const int row = u.pm * BM + ai * HALF + wr * 64 + m * 16 + fr; const float r = rs[ai][m];
#pragma unroll
                    for (int bj = 0; bj < 2; ++bj) *(u32x4e*)(O + (size_t)row * 512 + colt + bj * HALF + wc * 32 + 8 * fq) = pack8(acc[ai][bj][m][0] * r, acc[ai][bj][m][1] * r); }
        }
    }
};
struct EpiFfn {
    static constexpr bool PERM = true, AFTER_DRAIN = false, INIT_ACC = false, ROWSCALE = true;
    unsigned char* ws; PG8_LAS unsigned char* lds;
    __device__ __forceinline__ void operator()(const f32x4 (&acc)[2][2][4][2], const Unit& u, int wr, int wc, int fr, int fq) const {
        const float* stats = (const float*)(ws + XWS_STATS); bf16_t* ACT = (bf16_t*)(ws + XWS_ACT);
        float rs[2][4]; load_rowscale(rs, lds, u, wr, fr);
#pragma unroll
        for (int ai = 0; ai < 2; ++ai)
#pragma unroll
            for (int m = 0; m < 4; ++m) { const int row = u.pm * BM + ai * HALF + wr * 64 + m * 16 + fr; const float r = rs[ai][m];
                f32x4 o[2];
#pragma unroll
                for (int n = 0; n < 2; ++n) { const f32x4 g = acc[ai][0][m][n] * r, uu = acc[ai][1][m][n] * r; o[n] = g * sigmoid4(g) * uu; }
                *(u32x4e*)(ACT + (size_t)row * 2816 + u.pn * 128 + wc * 32 + 8 * fq) = pack8(o[0], o[1]); }
    }
};
__device__ __forceinline__ float bf_lo_(unsigned w) { return __builtin_bit_cast(float, w << 16); }
__device__ __forceinline__ float bf_hi_(unsigned w) { return __builtin_bit_cast(float, w & 0xffff0000u); }
__device__ __forceinline__ void split8(const f32x4 x0, const f32x4 x1, u32x4e& hi, u32x4e& lo) {
    hi = pack8(x0, x1);
    const f32x4 r0 = {x0[0] - bf_lo_(hi.x), x0[1] - bf_hi_(hi.x), x0[2] - bf_lo_(hi.y), x0[3] - bf_hi_(hi.y)}, r1 = {x1[0] - bf_lo_(hi.z), x1[1] - bf_hi_(hi.z), x1[2] - bf_lo_(hi.w), x1[3] - bf_hi_(hi.w)};
    lo = pack8(r0, r1);
}
__device__ __forceinline__ void join8(const u32x4e hi, const u32x4e lo, f32x4& x0, f32x4& x1) {
    x0 = (f32x4){bf_lo_(hi.x) + bf_lo_(lo.x), bf_hi_(hi.x) + bf_hi_(lo.x), bf_lo_(hi.y) + bf_lo_(lo.y), bf_hi_(hi.y) + bf_hi_(lo.y)};
    x1 = (f32x4){bf_lo_(hi.z) + bf_lo_(lo.z), bf_hi_(hi.z) + bf_hi_(lo.z), bf_lo_(hi.w) + bf_lo_(lo.w), bf_hi_(hi.w) + bf_hi_(lo.w)};
}
template <bool BASE_F32, bool RLO = true, bool WLO = true> struct EpiRes {
    static constexpr bool PERM = true, AFTER_DRAIN = false, INIT_ACC = true, ROWSCALE = false;
    unsigned char* ws; const float* base_p; const float* base_s;
    __device__ __forceinline__ void init(f32x4 (&acc)[2][2][4][2], const Unit& u, int wr, int wc, int fr, int fq) const {
        const int col0 = u.pn * BM + wc * 32 + 8 * fq;
        const bf16_t* HI = (const bf16_t*)(ws + XWS_XN); const bf16_t* LO = (const bf16_t*)(ws + XWS_LO);
#pragma unroll
        for (int ai = 0; ai < 2; ++ai)
#pragma unroll
            for (int m = 0; m < 4; ++m) { const int row = u.pm * BM + ai * HALF + wr * 64 + m * 16 + fr;
                if constexpr (BASE_F32) { const float* b = row < NROWS_P ? base_p + (size_t)row * 1024 : base_s + (size_t)(row - NROWS_P) * 1024;
#pragma unroll
                    for (int bj = 0; bj < 2; ++bj) { acc[ai][bj][m][0] = __builtin_nontemporal_load((const f32x4*)(b + col0 + bj * HALF)); acc[ai][bj][m][1] = __builtin_nontemporal_load((const f32x4*)(b + col0 + bj * HALF + 4)); }
                } else {
#pragma unroll
                    for (int bj = 0; bj < 2; ++bj) { const size_t o = (size_t)row * 1024 + col0 + bj * HALF;
                        if constexpr (RLO) join8(*(const u32x4e*)(HI + o), *(const u32x4e*)(LO + o), acc[ai][bj][m][0], acc[ai][bj][m][1]);
                        else { const u32x4e hi = *(const u32x4e*)(HI + o); acc[ai][bj][m][0] = (f32x4){bf_lo_(hi.x), bf_hi_(hi.x), bf_lo_(hi.y), bf_hi_(hi.y)}; acc[ai][bj][m][1] = (f32x4){bf_lo_(hi.z), bf_hi_(hi.z), bf_lo_(hi.w), bf_hi_(hi.w)}; } } } }
    }
    __device__ __forceinline__ void init_slab(f32x4 (&s)[2], const Unit& u, int wr, int wc, int fr, int fq) const {
        const bf16_t* HI = (const bf16_t*)(ws + XWS_XN);
        const u32x4e hi = *(const u32x4e*)(HI + (size_t)(NROWS_P + 16 * u.pm + fr) * 1024 + u.pn * BM + wr * HALF + wc * 32 + 8 * fq);
        s[0] = (f32x4){bf_lo_(hi.x), bf_hi_(hi.x), bf_lo_(hi.y), bf_hi_(hi.y)}; s[1] = (f32x4){bf_lo_(hi.z), bf_hi_(hi.z), bf_lo_(hi.w), bf_hi_(hi.w)};
    }
    __device__ __forceinline__ void slab_store(const f32x4 (&s)[2], const Unit& u, int wr, int wc, int fr, int fq, PG8_LAS unsigned char* lds) const {
        bf16_t* HI = (bf16_t*)(ws + XWS_XN);
        *(u32x4e*)(HI + (size_t)(NROWS_P + 16 * u.pm + fr) * 1024 + u.pn * BM + wr * HALF + wc * 32 + 8 * fq) = pack8(s[0], s[1]);
        const f32x4 x0 = s[0], x1 = s[1];
        float ss = (x0[0] * x0[0] + x0[1] * x0[1]) + (x0[2] * x0[2] + x0[3] * x0[3]) + (x1[0] * x1[0] + x1[1] * x1[1]) + (x1[2] * x1[2] + x1[3] * x1[3]);
        ss += __shfl_xor(ss, 16); ss += __shfl_xor(ss, 32);
        PG8_LAS float* X = (PG8_LAS float*)(lds + RS_OFF);
        if (fq == 0) X[(wr * 4 + wc) * 16 + fr] = ss;
    }
    __device__ __forceinline__ void slab_stats(const Unit& u, int wr, int wc, int fr, int fq, PG8_LAS unsigned char* lds) const {
        float* stats = (float*)(ws + XWS_STATS); const PG8_LAS float* X = (const PG8_LAS float*)(lds + RS_OFF);
        if (wr == 0 && fq == 0) stats[(size_t)(NROWS_P + 16 * u.pm + fr) * 16 + 4 * u.pn + wc] = X[wc * 16 + fr] + X[(4 + wc) * 16 + fr];
    }
    __device__ __forceinline__ void operator()(const f32x4 (&acc)[2][2][4][2], const Unit& u, int wr, int wc, int fr, int fq) const {
        bf16_t* HI = (bf16_t*)(ws + XWS_XN); bf16_t* LO = (bf16_t*)(ws + XWS_LO); float* stats = (float*)(ws + XWS_STATS);
        const int col0 = u.pn * BM + wc * 32 + 8 * fq;
#pragma unroll
        for (int ai = 0; ai < 2; ++ai)
#pragma unroll
            for (int m = 0; m < 4; ++m) { const int row = u.pm * BM + ai * HALF + wr * 64 + m * 16 + fr; float ss = 0.f;
#pragma unroll
                for (int bj = 0; bj < 2; ++bj) { const size_t o = (size_t)row * 1024 + col0 + bj * HALF;
                    const f32x4 x0 = acc[ai][bj][m][0], x1 = acc[ai][bj][m][1];
                    ss += (x0[0] * x0[0] + x0[1] * x0[1]) + (x0[2] * x0[2] + x0[3] * x0[3]) + (x1[0] * x1[0] + x1[1] * x1[1]) + (x1[2] * x1[2] + x1[3] * x1[3]);
                    if constexpr (WLO) { u32x4e hi, lo; split8(x0, x1, hi, lo); *(u32x4e*)(HI + o) = hi; *(u32x4e*)(LO + o) = lo; } else *(u32x4e*)(HI + o) = pack8(x0, x1); }
                ss += __shfl_xor(ss, 16); ss += __shfl_xor(ss, 32);
                if (fq == 0) stats[(size_t)row * 16 + 4 * u.pn + wc] = ss; }
    }
};
using EpiRes0 = EpiRes<true, false, false>; using EpiResM = EpiRes<false, false, false>; using EpiResL = EpiRes<false, false, true>;

template <class Epi, class Sched, bool ALIGN_EPI = false, bool SP2 = false, int SLAB = 0>
__device__ __forceinline__ void gemm_phase(PG8_LAS unsigned char* lds, const Gemm g, const Sched& S, const Epi& E, const int wid) {
    int lane_v; asm volatile("v_mbcnt_lo_u32_b32 %0, -1, 0\n\tv_mbcnt_hi_u32_b32 %0, -1, %0" : "=v"(lane_v)); const int lane = lane_v, tid = wid * 64 + lane, wr = wid >> 2, wc = wid & 3, fr = lane & 15, fq = lane >> 4;
    const int K = g.K, nt = K / BK;
    unsigned voffA[2], voffB[2];
#pragma unroll
    for (int i = 0; i < 2; ++i) { int R, C; stage_rc(tid * 16 + i * 8192, R, C); const int Rb = Epi::PERM ? ((R & ~31) + perm32(R & 31)) : R;
        voffA[i] = (unsigned)(R * K + C) * 2u; voffB[i] = (unsigned)(Rb * K + C) * 2u; }
    const size_t kstep = (size_t)(BK * 2);
    const size_t hstep = (size_t)HALF * K * 2;
    const size_t tstep = 2 * hstep;
    const unsigned ldsw = (unsigned)wid * 1024u;
    const int aoff = lds_byte(wr * 64 + fr, fq * 8), boff = lds_byte(wc * 32 + fr, fq * 8);
#define PG8_SA(b, h) (((b) * 2 + (h)) * HTB)
#define PG8_SB(b, h) ((4 + (b) * 2 + (h)) * HTB)
#define PG8_STAGE(bufoff, gbase, voff) do { _Pragma("unroll") for (int _i = 0; _i < 2; ++_i) \
        __builtin_amdgcn_global_load_lds((const unsigned*)((const char*)(gbase) + (voff)[_i]), (PG8_LAS unsigned*)(lds + (bufoff) + ldsw + _i * 8192), 16, 0, 0); } while (0)
#define PG8_LDA(dst, b, h) do { _Pragma("unroll") for (int m = 0; m < 4; ++m) _Pragma("unroll") for (int k = 0; k < 2; ++k) dst[m][k] = *(const PG8_LAS bf16x8*)(lds + PG8_SA(b, h) + aoff + m * 2048 + k * 1024); } while (0)
#define PG8_LDB(dst, b, h) do { _Pragma("unroll") for (int n = 0; n < 2; ++n) _Pragma("unroll") for (int k = 0; k < 2; ++k) dst[n][k] = *(const PG8_LAS bf16x8*)(lds + PG8_SB(b, h) + boff + n * 2048 + k * 1024); } while (0)
#define PG8_MMA(ai, bj, At, Bt) do { __builtin_amdgcn_s_setprio(1); _Pragma("unroll") for (int m = 0; m < 4; ++m) _Pragma("unroll") for (int n = 0; n < 2; ++n) _Pragma("unroll") for (int k = 0; k < 2; ++k) \
        acc[ai][bj][m][n] = __builtin_amdgcn_mfma_f32_16x16x32_bf16(Bt[n][k], At[m][k], acc[ai][bj][m][n], 0, 0, 0); __builtin_amdgcn_s_setprio(0); } while (0)
#define PG8_SL(b) (131072 + 4096 + (b) * 2048)
#define PG8_STAGE_S(b, gbase) do { if constexpr (SLAB != 0) { if (wid < 2) __builtin_amdgcn_global_load_lds((const unsigned*)((const char*)(gbase) + voffA[0]), (PG8_LAS unsigned*)(lds + PG8_SL(b) + ldsw), 16, 0, 0); } } while (0)
#define PG8_LDS_S(b) do { if constexpr (SLAB != 0) { Sf[0] = *(const PG8_LAS bf16x8*)(lds + PG8_SL(b) + soff); Sf[1] = *(const PG8_LAS bf16x8*)(lds + PG8_SL(b) + soff + 1024); } } while (0)
#define PG8_MMA_S() do { if constexpr (SLAB == 1) { __builtin_amdgcn_s_setprio(1); if (wr == 0) { _Pragma("unroll") for (int n = 0; n < 2; ++n) _Pragma("unroll") for (int k = 0; k < 2; ++k) accS[n] = __builtin_amdgcn_mfma_f32_16x16x32_bf16(B0[n][k], Sf[k], accS[n], 0, 0, 0); } \
        else { _Pragma("unroll") for (int n = 0; n < 2; ++n) _Pragma("unroll") for (int k = 0; k < 2; ++k) accS[n] = __builtin_amdgcn_mfma_f32_16x16x32_bf16(B1[n][k], Sf[k], accS[n], 0, 0, 0); } __builtin_amdgcn_s_setprio(0); } \
    else if constexpr (SLAB == 2) { __builtin_amdgcn_s_setprio(1); if (wr == 0) { _Pragma("unroll") for (int k = 0; k < 2; ++k) { accS[0] = __builtin_amdgcn_mfma_f32_16x16x32_bf16(B0[0][k], Sf[k], accS[0], 0, 0, 0); accS[1] = __builtin_amdgcn_mfma_f32_16x16x32_bf16(B1[0][k], Sf[k], accS[1], 0, 0, 0); } } \
        else { _Pragma("unroll") for (int k = 0; k < 2; ++k) { accS[0] = __builtin_amdgcn_mfma_f32_16x16x32_bf16(B0[1][k], Sf[k], accS[0], 0, 0, 0); accS[1] = __builtin_amdgcn_mfma_f32_16x16x32_bf16(B1[1][k], Sf[k], accS[1], 0, 0, 0); } } __builtin_amdgcn_s_setprio(0); } } while (0)
#define PG8_WAIT_V(n) asm volatile("s_waitcnt vmcnt(" #n ")" ::: "memory")
#define PG8_WAIT_L(n) asm volatile("s_waitcnt lgkmcnt(" #n ")" ::: "memory")
#define PG8_BAR __builtin_amdgcn_s_barrier()
#define PG8_SCHED __builtin_amdgcn_sched_barrier(0)
    Unit cur, nxt; int ui = 0;
    if (!S.next(0, cur)) return;
    f32x4 acc[2][2][4][2];
#pragma unroll
    for (int a = 0; a < 2; ++a)
#pragma unroll
        for (int b = 0; b < 2; ++b)
#pragma unroll
            for (int m = 0; m < 4; ++m)
#pragma unroll
                for (int n = 0; n < 2; ++n) acc[a][b][m][n] = (f32x4){0.f, 0.f, 0.f, 0.f};
    if constexpr (Epi::INIT_ACC) E.init(acc, cur, wr, wc, fr, fq);
    f32x4 accS[2]; bf16x8 Sf[2]; const int soff = lds_byte(fr, fq * 8);
    if constexpr (SLAB != 0) { static_assert(SP2 && ALIGN_EPI && !Epi::AFTER_DRAIN, "slab"); accS[0] = (f32x4){0.f, 0.f, 0.f, 0.f}; accS[1] = (f32x4){0.f, 0.f, 0.f, 0.f}; if constexpr (SLAB == 1 && Epi::INIT_ACC) E.init_slab(accS, cur, wr, wc, fr, fq); if constexpr (SLAB == 2) E.pre_slab(cur, wr, wc, fr, fq); }
    bf16x8 At[4][2], B0[2][2], B1[2][2];
    const char* cA = (const char*)g.A + (size_t)cur.pm * tstep; const char* cB = (const char*)g.Bt + (size_t)cur.pn * tstep;
    const size_t sstep = (size_t)16 * K * 2;
    const char* cS = (const char*)g.A + (size_t)16384 * K * 2 + (size_t)cur.pm * sstep;
    S.a_ready(cur);
    if constexpr (SP2) {
        PG8_STAGE_S(0, cS); PG8_STAGE(PG8_SB(0, 0), cB, voffB); PG8_STAGE(PG8_SB(0, 1), cB + hstep, voffB); PG8_STAGE(PG8_SA(0, 0), cA, voffA); PG8_STAGE(PG8_SA(0, 1), cA + hstep, voffA);
        if (wr == 1) PG8_BAR;
        PG8_WAIT_V(2); PG8_BAR;
        PG8_STAGE_S(1, cS + kstep); PG8_STAGE(PG8_SB(1, 0), cB + kstep, voffB); PG8_STAGE(PG8_SA(1, 0), cA + kstep, voffA); PG8_STAGE(PG8_SB(1, 1), cB + hstep + kstep, voffB);
        PG8_WAIT_V(6); PG8_BAR;
    } else {
        PG8_STAGE(PG8_SB(0, 0), cB, voffB); PG8_STAGE(PG8_SA(0, 0), cA, voffA); PG8_STAGE(PG8_SB(0, 1), cB + hstep, voffB); PG8_STAGE(PG8_SA(0, 1), cA + hstep, voffA);
        if (wr == 1) PG8_BAR;
        PG8_WAIT_V(4); PG8_BAR;
        PG8_STAGE(PG8_SB(1, 0), cB + kstep, voffB); PG8_STAGE(PG8_SA(1, 0), cA + kstep, voffA); PG8_STAGE(PG8_SB(1, 1), cB + hstep + kstep, voffB);
        PG8_WAIT_V(6); PG8_BAR;
    }
    for (;;) {
        const bool has_next = S.next(ui + 1, nxt);
        const char* nA = has_next ? (const char*)g.A + (size_t)nxt.pm * tstep : cA; const char* nB = has_next ? (const char*)g.Bt + (size_t)nxt.pn * tstep : cB;
        const char* nS = has_next ? (const char*)g.A + (size_t)16384 * K * 2 + (size_t)nxt.pm * sstep : cS;
        for (int t = 0; t < nt; t += 2) {
            const bool last = (t == nt - 2);
            const char* a1 = cA + (size_t)(t + 1) * kstep;
            const char* a2 = last ? nA : cA + (size_t)(t + 2) * kstep; const char* b2 = last ? nB : cB + (size_t)(t + 2) * kstep;
            const char* a3 = a2 + kstep; const char* b3 = b2 + kstep;
            const char* s2 = last ? nS : cS + (size_t)(t + 2) * kstep; const char* s3 = s2 + kstep;
            if (last && has_next) S.a_ready(nxt);
            if constexpr (SP2) {
            PG8_LDB(B0, 0, 0); PG8_LDB(B1, 0, 1); PG8_SCHED; PG8_LDA(At, 0, 0); PG8_LDS_S(0); PG8_STAGE(PG8_SA(1, 1), a1 + hstep, voffA);
            PG8_WAIT_V(8); PG8_WAIT_L(0); PG8_BAR; PG8_MMA(0, 0, At, B0); PG8_MMA(0, 1, At, B1); PG8_MMA_S(); PG8_BAR; PG8_SCHED;
            PG8_LDA(At, 0, 1); PG8_STAGE_S(0, s2); PG8_STAGE(PG8_SB(0, 0), b2, voffB); PG8_STAGE(PG8_SB(0, 1), b2 + hstep, voffB); PG8_STAGE(PG8_SA(0, 0), a2, voffA);
            PG8_WAIT_V(8); PG8_WAIT_L(0); PG8_BAR; PG8_MMA(1, 0, At, B0); PG8_MMA(1, 1, At, B1); PG8_BAR; PG8_SCHED;
            PG8_LDB(B0, 1, 0); PG8_LDB(B1, 1, 1); PG8_SCHED; PG8_LDA(At, 1, 0); PG8_LDS_S(1); PG8_STAGE(PG8_SA(0, 1), a2 + hstep, voffA);
            PG8_WAIT_V(8); PG8_WAIT_L(0); PG8_BAR; PG8_MMA(0, 0, At, B0); PG8_MMA(0, 1, At, B1); PG8_MMA_S(); PG8_BAR; PG8_SCHED;
            PG8_LDA(At, 1, 1); PG8_STAGE_S(1, s3); PG8_STAGE(PG8_SB(1, 0), b3, voffB); PG8_STAGE(PG8_SB(1, 1), b3 + hstep, voffB); PG8_STAGE(PG8_SA(1, 0), a3, voffA);
            PG8_WAIT_V(8); PG8_WAIT_L(0); PG8_BAR; PG8_MMA(1, 0, At, B0); PG8_MMA(1, 1, At, B1); PG8_BAR; PG8_SCHED;
            } else {
            PG8_LDB(B0, 0, 0); PG8_SCHED; PG8_LDA(At, 0, 0); PG8_STAGE(PG8_SA(1, 1), a1 + hstep, voffA);
            PG8_WAIT_L(8); PG8_BAR; PG8_WAIT_L(0); PG8_MMA(0, 0, At, B0); PG8_BAR; PG8_SCHED;
            PG8_LDB(B1, 0, 1); PG8_STAGE(PG8_SB(0, 0), b2, voffB);
            PG8_BAR; PG8_WAIT_L(0); PG8_MMA(0, 1, At, B1); PG8_BAR;
            PG8_LDA(At, 0, 1); PG8_STAGE(PG8_SA(0, 0), a2, voffA);
            PG8_BAR; PG8_WAIT_L(0); PG8_MMA(1, 0, At, B0); PG8_BAR; PG8_SCHED;
            PG8_STAGE(PG8_SB(0, 1), b2 + hstep, voffB);
            PG8_WAIT_V(6); PG8_BAR; PG8_MMA(1, 1, At, B1); PG8_BAR;
            PG8_LDB(B0, 1, 0); PG8_SCHED; PG8_LDA(At, 1, 0); PG8_STAGE(PG8_SA(0, 1), a2 + hstep, voffA);
            PG8_WAIT_L(8); PG8_BAR; PG8_WAIT_L(0); PG8_MMA(0, 0, At, B0); PG8_BAR; PG8_SCHED;
            PG8_LDB(B1, 1, 1); PG8_STAGE(PG8_SB(1, 0), b3, voffB);
            PG8_BAR; PG8_WAIT_L(0); PG8_MMA(0, 1, At, B1); PG8_BAR;
            PG8_LDA(At, 1, 1); PG8_STAGE(PG8_SA(1, 0), a3, voffA);
            PG8_BAR; PG8_WAIT_L(0); PG8_MMA(1, 0, At, B0); PG8_BAR; PG8_SCHED;
            PG8_STAGE(PG8_SB(1, 1), b3 + hstep, voffB);
            PG8_WAIT_V(6); PG8_BAR; PG8_MMA(1, 1, At, B1); PG8_BAR;
            }
        }
        if constexpr (ALIGN_EPI) { if (wr == 0) PG8_BAR; }
        if constexpr (!Epi::AFTER_DRAIN) { E(acc, cur, wr, wc, fr, fq); S.done(cur); }
        if constexpr (SLAB == 1) { E.slab_store(accS, cur, wr, wc, fr, fq, lds); PG8_WAIT_L(0); PG8_BAR; E.slab_stats(cur, wr, wc, fr, fq, lds); }
        if constexpr (SLAB == 2) E.slab_out(accS, cur, wr, wc, fr, fq);
        if (!has_next) break;
#pragma unroll
        for (int a = 0; a < 2; ++a)
#pragma unroll
            for (int b = 0; b < 2; ++b)
#pragma unroll
                for (int m = 0; m < 4; ++m)
#pragma unroll
                    for (int n = 0; n < 2; ++n) acc[a][b][m][n] = (f32x4){0.f, 0.f, 0.f, 0.f};
        if constexpr (Epi::INIT_ACC) E.init(acc, nxt, wr, wc, fr, fq);
        if constexpr (SLAB != 0) { accS[0] = (f32x4){0.f, 0.f, 0.f, 0.f}; accS[1] = (f32x4){0.f, 0.f, 0.f, 0.f}; if constexpr (SLAB == 1 && Epi::INIT_ACC) E.init_slab(accS, nxt, wr, wc, fr, fq); if constexpr (SLAB == 2) E.pre_slab(nxt, wr, wc, fr, fq); cS = nS; }
        cur = nxt; cA = nA; cB = nB; ++ui;
        if constexpr (ALIGN_EPI) { if (wr == 1) PG8_BAR; }
    }
    PG8_WAIT_V(0);
    if constexpr (!ALIGN_EPI) { if (wr == 0) PG8_BAR; }
    PG8_BAR;
    if constexpr (Epi::AFTER_DRAIN) { E.fused(acc, cur, wr, wc, fr, fq, lds, wid, lane); S.done(cur); }
#undef PG8_SA
#undef PG8_SB
#undef PG8_STAGE
#undef PG8_LDA
#undef PG8_LDB
#undef PG8_MMA
#undef PG8_SL
#undef PG8_STAGE_S
#undef PG8_LDS_S
#undef PG8_MMA_S
#undef PG8_WAIT_V
#undef PG8_WAIT_L
#undef PG8_BAR
#undef PG8_SCHED
}
}
constexpr int NWAVES = 8;
constexpr int DM = 1024, MP = 16384, MS = 1024, MT = MP + MS;
constexpr int SEQ = 2048, DSEQ = 8, NB = 8, NDB = 128, PAST = 2048, PAGE = 128, NPAGES = 16;
constexpr int CD_ = 512, CW = 31, NH = 8, HD = 64, FFN = 2816;
constexpr int N_IN_E = 2560, N_IN_O = 2048, N_FF = 2 * FFN;
constexpr float EPS = 1e-6f;
constexpr float LOG2E = 1.4426950408889634f;
constexpr float QSCALE = 0.125f * LOG2E;

constexpr size_t O_Y = 0, O_KP = (size_t)MT * DM, O_VP = O_KP + (size_t)MP * 512, O_KS = O_VP + (size_t)MP * 512, O_VS = O_KS + (size_t)MS * 512;
constexpr size_t O_CONVP = O_VS + (size_t)MS * 512, O_CONVS = O_CONVP + (size_t)NB * 30 * 512, O_SCP = O_CONVS + (size_t)NDB * 30 * 512, O_SCS = O_SCP + (size_t)NB * 2 * 512;
constexpr size_t O_POOLP = O_SCS + (size_t)NDB * 2 * 512, O_POOLS = O_POOLP + (size_t)NB * 15 * 512, O_END = O_POOLS + (size_t)NDB * 15 * 512;
static_assert(O_END == 38924288, "d_out map");

constexpr size_t MiB = 1u << 20;
constexpr size_t WS_CTL = 0, CTL_ZERO_BYTES = 64 * 1024;
constexpr size_t WS_WE_IN = 2 * MiB, WS_WE_OUT = 7 * MiB, WS_WO_IN = 9 * MiB, WS_WO_OUT = 13 * MiB, WS_WF_IN = 15 * MiB  , WS_WF_OUT = 37 * MiB  ;
constexpr size_t WS_POOLWT = 49 * MiB, WS_STATS = 50 * MiB, WS_XN = 52 * MiB, WS_GLU = 86 * MiB, WS_Q = 103 * MiB, WS_K = 120 * MiB, WS_V = 137 * MiB, WS_AB = 154 * MiB, WS_ACT = 188 * MiB, WS_LO = 282 * MiB, WS_END = 316 * MiB;
constexpr size_t WS_GB = WS_GLU, WS_CX = WS_Q, WS_U = WS_K, WS_CDD = WS_AB;
static_assert(WS_LO == pg8::XWS_LO && WS_LO + (size_t)MT * DM * 2 <= WS_END && WS_STATS == pg8::XWS_STATS && WS_XN == pg8::XWS_XN && WS_GLU == pg8::XWS_GLU && WS_Q == pg8::XWS_Q && WS_K == pg8::XWS_K && WS_V == pg8::XWS_V && WS_AB == pg8::XWS_AB && WS_ACT == pg8::XWS_ACT && O_KP == pg8::XO_KP && O_VS == pg8::XO_VS, "maps");
static_assert(WS_XN + (size_t)MT * DM * 2 <= WS_GLU && WS_GLU + (size_t)MT * 512 * 2 <= WS_Q && WS_AB + (size_t)MT * DM * 2 <= WS_ACT && WS_ACT + (size_t)MT * FFN * 2 <= WS_LO, "d_ws map");
constexpr int CW_BAR = 4096;
static_assert((CW_BAR + 3456) * 4 <= (int)CTL_ZERO_BYTES, "barrier words inside the zeroed region");

constexpr int RING_OFF = 0, RING_BYTES = 139264;
constexpr int LDSCTL_OFF = RING_BYTES, MISC_OFF = LDSCTL_OFF + 320;
constexpr int LDS_BYTES = 147456;
static_assert(MISC_OFF + 128 <= LDS_BYTES, "LDS map");

#define GAS __attribute__((address_space(1)))
#define LAS __attribute__((address_space(3)))
typedef unsigned short bf16;
typedef unsigned v4u __attribute__((ext_vector_type(4)));
typedef unsigned v2u __attribute__((ext_vector_type(2)));
typedef float f32x4 __attribute__((ext_vector_type(4)));
typedef float f32x2 __attribute__((ext_vector_type(2)));
typedef GAS unsigned gu32;
#define RLX_AGENT __ATOMIC_RELAXED, __HIP_MEMORY_SCOPE_AGENT
#define LDS_WAIT() asm volatile("s_waitcnt lgkmcnt(0)" ::: "memory")
#define VM_WAIT() asm volatile("s_waitcnt vmcnt(0)" ::: "memory")
__device__ __forceinline__ unsigned f2bf(float f) { unsigned u = __builtin_bit_cast(unsigned, f); return (u + 0x7fffu + ((u >> 16) & 1u)) >> 16; }
__device__ __forceinline__ unsigned pk2(float lo, float hi) { return f2bf(lo) | (f2bf(hi) << 16); }
typedef float pkf2_t __attribute__((ext_vector_type(2))); typedef __bf16 pkb2_t __attribute__((ext_vector_type(2)));
__device__ __forceinline__ unsigned pk2h(float lo, float hi) { pkf2_t v = {lo, hi}; pkb2_t b = __builtin_convertvector(v, pkb2_t); return __builtin_bit_cast(unsigned, b); }
__device__ __forceinline__ float bf2f(unsigned b) { return __builtin_bit_cast(float, b << 16); }
__device__ __forceinline__ float bflo(unsigned w) { return __builtin_bit_cast(float, w << 16); }
__device__ __forceinline__ float bfhi(unsigned w) { return __builtin_bit_cast(float, w & 0xffff0000u); }
__device__ __forceinline__ float ex2(float x) { return __builtin_amdgcn_exp2f(x); }
__device__ __forceinline__ float lg2(float x) { return __builtin_amdgcn_logf(x); }
__device__ __forceinline__ float sigm(float x) { return __builtin_amdgcn_rcpf(1.0f + ex2(-LOG2E * x)); }

#define XB_TMO      128
#define XB_XCNT(j)  (256  + 64 * (j))
#define XB_XSUB(j)  (1280 + 64 * (j))
#define XB_XGEN(j)  (2304 + 64 * (j))
#define XB_TOP      3328
#define XB_TOPGEN   3392
#define XCD_BAR_WORDS 3456
#define XB_SPIN_CAP (1u << 18)

__device__ __forceinline__ unsigned xb_ld(unsigned* p)              { return __hip_atomic_load(p, __ATOMIC_RELAXED, __HIP_MEMORY_SCOPE_AGENT); }
__device__ __forceinline__ unsigned xb_add(unsigned* p, unsigned v) { return __hip_atomic_fetch_add(p, v, __ATOMIC_RELAXED, __HIP_MEMORY_SCOPE_AGENT); }
__device__ __forceinline__ unsigned xb_xcc_id() { return (unsigned)__builtin_amdgcn_s_getreg((3 << 11) | 20) & 0xFu; }
#define XB_SPIN(cond, bar) do { unsigned _sp = 0; while (cond) { __builtin_amdgcn_s_sleep(1); \
    if ((++_sp & 255u) == 0u) { if (xb_ld(&(bar)[XB_TMO])) break; if (_sp > XB_SPIN_CAP) { atomicAdd(&(bar)[XB_TMO], 1u); break; } } } } while (0)

struct XcdBarrier {
    unsigned* bar; unsigned x; int wv;
    volatile LAS unsigned* st;
};

__device__ __forceinline__ bool xb_thread0(int wv) { unsigned l; asm volatile("v_mbcnt_lo_u32_b32 %0, -1, 0\n\tv_mbcnt_hi_u32_b32 %0, -1, %0" : "=v"(l)); return wv == 0 && l == 0u; }
__device__ __forceinline__ XcdBarrier xcd_barrier_post(unsigned* bar, volatile LAS unsigned* st, int wv) {
    XcdBarrier b; b.bar = bar; b.x = xb_xcc_id(); b.st = st; b.wv = wv;
    if (xb_thread0(wv)) (void)xb_add(&bar[XB_XCNT(b.x)], 1u);
    return b;
}
__device__ __forceinline__ void xcd_barrier_complete(unsigned* bar, unsigned x, unsigned& nloc, unsigned& nx) {
    const unsigned G = gridDim.x * gridDim.y * gridDim.z;
    unsigned sum, cnt, mine, sp = 0u;
    for (;;) {
        sum = 0u; cnt = 0u; mine = 0u;
#pragma unroll
        for (unsigned j = 0; j < 16; ++j) { const unsigned c = xb_ld(&bar[XB_XCNT(j)]); sum += c; cnt += (c > 0u) ? 1u : 0u; mine = (j == x) ? c : mine; }
        if (sum == G) break;
        __builtin_amdgcn_s_sleep(1);
        if ((++sp & 255u) == 0u) { if (xb_ld(&bar[XB_TMO])) break; if (sp > XB_SPIN_CAP) { atomicAdd(&bar[XB_TMO], 1u); break; } }
    }
    nloc = mine > 0u ? mine : 1u; nx = cnt > 0u ? cnt : 1u;
}

__device__ __forceinline__ void xcd_barrier(const XcdBarrier& b) {
    asm volatile("s_waitcnt vmcnt(0)" ::: "memory");
    __syncthreads();
    if (xb_thread0(b.wv)) {
        unsigned* bar = b.bar;
        __builtin_amdgcn_s_waitcnt(0);
        unsigned nloc = b.st[0], nx = b.st[1];
        if (nloc == 0u) { xcd_barrier_complete(bar, b.x, nloc, nx); b.st[0] = nloc; b.st[1] = nx; }
        const unsigned old = xb_add(&bar[XB_XSUB(b.x)], 1u);
        const unsigned gen = old / nloc;
        if (old + 1u == (gen + 1u) * nloc) {
            __builtin_amdgcn_fence(__ATOMIC_RELEASE, "agent");
            asm volatile("s_waitcnt vmcnt(0)" ::: "memory");
            const unsigned og = xb_add(&bar[XB_TOP], 1u);
            const unsigned tg = og / nx;
            if (og + 1u == (tg + 1u) * nx) xb_add(&bar[XB_TOPGEN], 1u);
            else XB_SPIN(xb_ld(&bar[XB_TOPGEN]) == tg, bar);
            __builtin_amdgcn_fence(__ATOMIC_ACQUIRE, "agent");
            xb_add(&bar[XB_XGEN(b.x)], 1u);
            asm volatile("s_waitcnt vmcnt(0)" ::: "memory");
        } else {
            XB_SPIN(xb_ld(&bar[XB_XGEN(b.x)]) == gen, bar);
            __builtin_amdgcn_fence(__ATOMIC_ACQUIRE, "agent");
            asm volatile("s_waitcnt vmcnt(0)" ::: "memory");
        }
    }
    __syncthreads();
}
namespace sba {
using bf16x8 = __attribute__((ext_vector_type(8))) short;
using s16x4 = __attribute__((ext_vector_type(4))) short;
using f32x16 = __attribute__((ext_vector_type(16))) float;
using u32x4 = __attribute__((ext_vector_type(4))) unsigned;
constexpr int NSLOT = 3, SLOTB = 8192, L_K = 0, L_V = NSLOT * SLOTB, L_OST = 2 * NSLOT * SLOTB, L_BYTES = L_OST + 8 * 4096;
constexpr int PQ = 512, PO = 1024;
__device__ __forceinline__ int crow(int r, int hi) { return (r & 3) + 8 * (r >> 2) + 4 * hi; }
__device__ __forceinline__ void glds16(const void* gbase  , unsigned voff  , unsigned lds_dst) { unsigned keep;
    asm volatile("s_mov_b32 %0, m0\n\ts_mov_b32 m0, %3\n\ts_nop 0\n\tglobal_load_lds_dwordx4 %1, %2\n\ts_mov_b32 m0, %0" : "=&s"(keep) : "v"(voff), "s"(gbase), "s"(lds_dst) : "memory"); }
__device__ __forceinline__ int fresh_lane() { int l; asm volatile("v_mbcnt_lo_u32_b32 %0, -1, 0\n\tv_mbcnt_hi_u32_b32 %0, -1, %0" : "=v"(l)); return l; }
typedef float f32x2_t __attribute__((ext_vector_type(2))); typedef __bf16 bf16x2_t __attribute__((ext_vector_type(2)));
__device__ __forceinline__ unsigned cvtpk(float lo, float hi) { f32x2_t v = {lo, hi}; bf16x2_t b = __builtin_convertvector(v, bf16x2_t); return __builtin_bit_cast(unsigned, b); }
#define SBA_WAIT_BAR(N) asm volatile("s_waitcnt vmcnt(" #N ") lgkmcnt(0)\n\ts_barrier" ::: "memory")
typedef __attribute__((address_space(3))) const char* lcp;
__device__ __forceinline__ void qkt(f32x16& p0, f32x16& p1, lcp Kslot, const bf16x8* qr, const f32x16& cin, int r32, int hi) {
    lcp kb = Kslot + hi * 1024 + r32 * 16;
#pragma unroll
    for (int d0 = 0; d0 < 4; ++d0) {
        const bf16x8 b0 = *(const __attribute__((address_space(3))) bf16x8*)(kb + d0 * 2048);
        const bf16x8 b1 = *(const __attribute__((address_space(3))) bf16x8*)(kb + d0 * 2048 + 512);
        if (d0 == 0) { p0 = __builtin_amdgcn_mfma_f32_32x32x16_bf16(b0, qr[0], cin, 0, 0, 0); p1 = __builtin_amdgcn_mfma_f32_32x32x16_bf16(b1, qr[0], cin, 0, 0, 0); }
        else { p0 = __builtin_amdgcn_mfma_f32_32x32x16_bf16(b0, qr[d0], p0, 0, 0, 0); p1 = __builtin_amdgcn_mfma_f32_32x32x16_bf16(b1, qr[d0], p1, 0, 0, 0); } }
}
__device__ __forceinline__ void pv(f32x16* o, int vb, bf16x8 pa0, bf16x8 pa1, bf16x8 pa2, bf16x8 pa3) {
#pragma unroll
    for (int d0 = 0; d0 < 2; ++d0) { s16x4 lo[4], hi[4];
#pragma unroll
        for (int ks = 0; ks < 4; ++ks) {
            asm volatile("ds_read_b64_tr_b16 %0,%1 offset:%c2" : "=&v"(lo[ks]) : "v"(vb), "i"(d0 * 4096 + ks * 1024) : "memory");
            asm volatile("ds_read_b64_tr_b16 %0,%1 offset:%c2" : "=&v"(hi[ks]) : "v"(vb), "i"(d0 * 4096 + ks * 1024 + 512) : "memory"); }
        asm volatile("s_waitcnt lgkmcnt(0)" ::: "memory"); __builtin_amdgcn_sched_barrier(0);
#define SBA_PK(k) (bf16x8){lo[k][0], lo[k][1], lo[k][2], lo[k][3], hi[k][0], hi[k][1], hi[k][2], hi[k][3]}
        o[d0] = __builtin_amdgcn_mfma_f32_32x32x16_bf16(pa0, SBA_PK(0), o[d0], 0, 0, 0);
        o[d0] = __builtin_amdgcn_mfma_f32_32x32x16_bf16(pa1, SBA_PK(1), o[d0], 0, 0, 0);
        o[d0] = __builtin_amdgcn_mfma_f32_32x32x16_bf16(pa2, SBA_PK(2), o[d0], 0, 0, 0);
        o[d0] = __builtin_amdgcn_mfma_f32_32x32x16_bf16(pa3, SBA_PK(3), o[d0], 0, 0, 0);
#undef SBA_PK
    }
}
__device__ __forceinline__ float sp2(float z) { return fmaxf(z, 0.f) + __builtin_amdgcn_logf(1.0f + __builtin_amdgcn_exp2f(-__builtin_fabsf(z))); }
template <bool BAND> __device__ __forceinline__ void sb_tile(f32x16& p0, f32x16& p1, float& A, u32x4 (&pw)[4], int kv0, int qabs, int hi, float hsel) {
    float s0[16], s1[16];
#pragma unroll
    for (int r = 0; r < 16; ++r) { s0[r] = sp2(p0[r]); s1[r] = sp2(p1[r]);
        if (BAND) { const int kv = kv0 + crow(r, hi); if (kv >= qabs) s0[r] = 0.f; if (kv + 32 >= qabs) s1[r] = 0.f; } }
    float glo[8], ghi[8];
#pragma unroll
    for (int g = 0; g < 4; ++g) {
        const float a = (s0[4 * g] + s0[4 * g + 1]) + (s0[4 * g + 2] + s0[4 * g + 3]), b = (s1[4 * g] + s1[4 * g + 1]) + (s1[4 * g + 2] + s1[4 * g + 3]);
        auto ra = __builtin_amdgcn_permlane32_swap(__float_as_uint(a), __float_as_uint(a), false, false);
        auto rb = __builtin_amdgcn_permlane32_swap(__float_as_uint(b), __float_as_uint(b), false, false);
        glo[g] = __uint_as_float(ra[0]); ghi[g] = __uint_as_float(ra[1]); glo[4 + g] = __uint_as_float(rb[0]); ghi[4 + g] = __uint_as_float(rb[1]); }
    float run = A;
#pragma unroll
    for (int G = 7; G >= 0; --G) {
        float c = run + hsel * ghi[G];
        if (G < 4) {
#pragma unroll
            for (int i = 3; i >= 0; --i) { c += s0[4 * G + i]; const float w = __builtin_amdgcn_exp2f(p0[4 * G + i] - c); p0[4 * G + i] = w; }
        } else {
#pragma unroll
            for (int i = 3; i >= 0; --i) { c += s1[4 * (G - 4) + i]; const float w = __builtin_amdgcn_exp2f(p1[4 * (G - 4) + i] - c); p1[4 * (G - 4) + i] = w; }
        }
        run += glo[G] + ghi[G];
    }
    A = run;
    if (BAND) {
#pragma unroll
        for (int r = 0; r < 16; ++r) { const int kv = kv0 + crow(r, hi); if (kv >= qabs) p0[r] = 0.f; if (kv + 32 >= qabs) p1[r] = 0.f; }
    }
#pragma unroll
    for (int k = 0; k < 2; ++k) {
        pw[k] = (u32x4){cvtpk(p0[8 * k], p0[8 * k + 1]), cvtpk(p0[8 * k + 2], p0[8 * k + 3]), cvtpk(p0[8 * k + 4], p0[8 * k + 5]), cvtpk(p0[8 * k + 6], p0[8 * k + 7])};
        pw[2 + k] = (u32x4){cvtpk(p1[8 * k], p1[8 * k + 1]), cvtpk(p1[8 * k + 2], p1[8 * k + 3]), cvtpk(p1[8 * k + 4], p1[8 * k + 5]), cvtpk(p1[8 * k + 6], p1[8 * k + 7])}; }
}
__device__ __forceinline__ void bar4(__attribute__((address_space(3))) unsigned* cnt, unsigned& target, int lane) {
    target += 4u;
    if (lane == 0) __hip_atomic_fetch_add((unsigned*)cnt, 1u, __ATOMIC_RELAXED, __HIP_MEMORY_SCOPE_WORKGROUP);
    for (unsigned sp = 0; *(volatile __attribute__((address_space(3))) unsigned*)cnt < target && sp < (1u << 22); ++sp) __builtin_amdgcn_s_sleep(1);
    asm volatile("" ::: "memory");
}
constexpr int L_BAR4 = L_OST + 8 * 4096;
template <int NW> __device__ __forceinline__ void unitT(int b, int h, int qb, const unsigned short* Q, const unsigned short* K, const unsigned short* V, unsigned short* O, float bias2,
                                     __attribute__((address_space(3))) unsigned char* shm, int wid, unsigned& btarget) {
    constexpr int QB = 32 * NW, PCS = 8 / NW;
    const int lane = fresh_lane(); const int r32 = lane & 31, hi = lane >> 5;
    const long rowbase = (long)b * 2048; const int q0 = qb * QB;
    const unsigned short* Qw = Q + (rowbase + q0 + wid * 32) * PQ + h * 64;
    const unsigned short* Kh = K + rowbase * PQ + h * 64; const unsigned short* Vh = V + rowbase * PQ + h * 64;
    const unsigned lds0 = (unsigned)(uintptr_t)shm;
    __attribute__((address_space(3))) unsigned* bcnt = (__attribute__((address_space(3))) unsigned*)(shm + L_BAR4);
    const unsigned koffL = (unsigned)(lane * PQ) * 2u, voffL = (unsigned)((lane >> 2) * PQ + (lane & 3) * 8) * 2u;
#define SBA_DMA(t, slot) do { _Pragma("unroll") for (int pc_ = 0; pc_ < PCS; ++pc_) { const int pc = wid + NW * pc_; \
        glds16(Kh + (long)(t) * 64 * PQ + pc * 8, koffL, (unsigned)__builtin_amdgcn_readfirstlane(lds0 + L_K + pc * 1024 + (slot))); \
        glds16(Vh + (long)(t) * 64 * PQ + (long)(16 * (pc & 3)) * PQ + (pc >> 2) * 32, voffL, (unsigned)__builtin_amdgcn_readfirstlane(lds0 + L_V + pc * 1024 + (slot))); } } while (0)
#define SBA_SYNC() do { if constexpr (NW == 8) { asm volatile("s_barrier" ::: "memory"); } else { bar4(bcnt, btarget, lane); } } while (0)
    const int vb0 = (int)(lds0 + L_V) + ((lane >> 4) & 1) * 32 + (lane & 3) * 8 + (4 * hi + ((lane & 15) >> 2)) * 64;
    const lcp shm3 = (lcp)shm;
    const int NT = (q0 + QB) / 64;
    bf16x8 qr[4];
#pragma unroll
    for (int d0 = 0; d0 < 4; ++d0) qr[d0] = *reinterpret_cast<const bf16x8*>(&Qw[(long)r32 * PQ + d0 * 16 + hi * 8]);
    SBA_DMA(NT - 1, 0); SBA_DMA(NT - 2, SLOTB);
    float A = 0.f; f32x16 o[2]; o[0] = f32x16{}; o[1] = f32x16{};
    f32x16 cin;
#pragma unroll
    for (int r = 0; r < 16; ++r) cin[r] = bias2;
    const int qabs = q0 + wid * 32 + r32, qmin = q0 + wid * 32;
    const float hsel = hi == 0 ? 1.f : 0.f;
    int slot = 0, slot2 = 2 * SLOTB;
    for (int i = 0; i < NT; ++i) {
        const int t = NT - 1 - i;
        if (i + 1 < NT) { if constexpr (NW == 8) asm volatile("s_waitcnt vmcnt(2) lgkmcnt(0)" ::: "memory"); else asm volatile("s_waitcnt vmcnt(4) lgkmcnt(0)" ::: "memory"); }
        else asm volatile("s_waitcnt vmcnt(0) lgkmcnt(0)" ::: "memory");
        SBA_SYNC();
        if (i + 2 < NT) SBA_DMA(t - 2, slot2);
        const int kv0 = 64 * t;
        if (kv0 < qmin + 31) {
            f32x16 p0, p1; u32x4 pw[4];
            qkt(p0, p1, shm3 + L_K + slot, qr, cin, r32, hi);
            if (kv0 + 63 >= qmin) sb_tile<true>(p0, p1, A, pw, kv0, qabs, hi, hsel); else sb_tile<false>(p0, p1, A, pw, kv0, qabs, hi, hsel);
            pv(o, vb0 + slot, __builtin_bit_cast(bf16x8, pw[0]), __builtin_bit_cast(bf16x8, pw[1]), __builtin_bit_cast(bf16x8, pw[2]), __builtin_bit_cast(bf16x8, pw[3]));
        }
        slot = slot == 2 * SLOTB ? 0 : slot + SLOTB; slot2 = slot2 == 2 * SLOTB ? 0 : slot2 + SLOTB;
    }
    unsigned short* Ow = O + (rowbase + q0 + wid * 32) * PO + h * 64;
    { const int lane = fresh_lane(); const int r32 = lane & 31, hi = lane >> 5; __attribute__((address_space(3))) unsigned short* stg = (__attribute__((address_space(3))) unsigned short*)(shm + L_OST) + wid * 2048;
#pragma unroll
        for (int r = 0; r < 16; ++r) { const int orow = crow(r, hi);
#pragma unroll
            for (int d0 = 0; d0 < 2; ++d0) stg[orow * 64 + d0 * 32 + r32] = (unsigned short)(cvtpk(o[d0][r], 0.f) & 0xffffu); }
        asm volatile("s_waitcnt lgkmcnt(0)" ::: "memory");
#pragma unroll
        for (int i = 0; i < 4; ++i) { const int row = i * 8 + (lane >> 3), ch = lane & 7; const u32x4 v = *(const __attribute__((address_space(3))) u32x4*)(stg + row * 64 + ch * 8); *(u32x4*)(Ow + (long)row * PO + ch * 8) = v; } }
    asm volatile("s_waitcnt lgkmcnt(0)" ::: "memory");
    SBA_SYNC();
#undef SBA_DMA
#undef SBA_SYNC
}
constexpr int P4_RK = 4, P4_RV = 5, P4_LV = P4_RK * SLOTB, P4_BAR = (P4_RK + P4_RV) * SLOTB, P4_BYTES = P4_BAR + 256;
__device__ __forceinline__ void unitP4(int b, int h, int qb, const unsigned short* Q, const unsigned short* K, const unsigned short* V, unsigned short* O, float bias2,
                                       __attribute__((address_space(3))) unsigned char* shm, int wid, unsigned& btarget) {
    const int lane = fresh_lane(); const int r32 = lane & 31, hi = lane >> 5;
    const long rowbase = (long)b * 2048; const int q0 = qb * 128;
    const unsigned short* Qw = Q + (rowbase + q0 + wid * 32) * PQ + h * 64;
    const unsigned short* Kh = K + rowbase * PQ + h * 64; const unsigned short* Vh = V + rowbase * PQ + h * 64;
    const unsigned lds0 = (unsigned)(uintptr_t)shm;
    __attribute__((address_space(3))) unsigned* bcnt = (__attribute__((address_space(3))) unsigned*)(shm + P4_BAR);
    const int NT = (q0 + 128) / 64;
#define P4_DMA(j, ks, vs) do { const long t_ = (long)(NT - 1 - (j)); const int ln_ = fresh_lane(); const unsigned koffL = (unsigned)(ln_ * PQ) * 2u, voffL = (unsigned)((ln_ >> 2) * PQ + (ln_ & 3) * 8) * 2u;     _Pragma("unroll") for (int pc_ = 0; pc_ < 2; ++pc_) { const int pc = wid + 4 * pc_; \
        glds16(Kh + t_ * 64 * PQ + pc * 8, koffL, (unsigned)__builtin_amdgcn_readfirstlane(lds0 + pc * 1024 + (ks))); \
        glds16(Vh + t_ * 64 * PQ + (long)(16 * (pc & 3)) * PQ + (pc >> 2) * 32, voffL, (unsigned)__builtin_amdgcn_readfirstlane(lds0 + P4_LV + pc * 1024 + (vs))); } } while (0)
#define P4_WAIT(i) do { if ((i) + 2 < NT) asm volatile("s_waitcnt vmcnt(4) lgkmcnt(0)" ::: "memory"); else asm volatile("s_waitcnt vmcnt(0) lgkmcnt(0)" ::: "memory"); bar4(bcnt, btarget, lane); } while (0)
    const int vb0 = (int)(lds0 + P4_LV) + ((lane >> 4) & 1) * 32 + (lane & 3) * 8 + (4 * hi + ((lane & 15) >> 2)) * 64;
    const lcp shm3 = (lcp)shm;
    bf16x8 qr[4];
#pragma unroll
    for (int d0 = 0; d0 < 4; ++d0) qr[d0] = *reinterpret_cast<const bf16x8*>(&Qw[(long)r32 * PQ + d0 * 16 + hi * 8]);
    P4_DMA(0, 0, 0); P4_DMA(1, SLOTB, SLOTB); if (NT > 2) P4_DMA(2, 2 * SLOTB, 2 * SLOTB);
    float A = 0.f; f32x16 o[2]; o[0] = f32x16{}; o[1] = f32x16{};
    f32x16 cin;
#pragma unroll
    for (int r = 0; r < 16; ++r) cin[r] = bias2;
    const int qabs = q0 + wid * 32 + r32, qmin = q0 + wid * 32;
    const float hsel = hi == 0 ? 1.f : 0.f;
    int ks3 = 3 * SLOTB, vs3 = 3 * SLOTB;
#define P4_ADV() do { ks3 = ks3 == (P4_RK - 1) * SLOTB ? 0 : ks3 + SLOTB; vs3 = vs3 == (P4_RV - 1) * SLOTB ? 0 : vs3 + SLOTB; } while (0)
#pragma nounroll
    for (int i = 0; i < 2; ++i) {
        P4_WAIT(i);
        if (i + 3 < NT) P4_DMA(i + 3, ks3, vs3);
        P4_ADV();
        const int kv0 = 64 * (NT - 1 - i);
        if (kv0 < qmin + 31) {
            f32x16 p0, p1; u32x4 pw[4];
            qkt(p0, p1, shm3 + i * SLOTB, qr, cin, r32, hi);
            if (kv0 + 63 >= qmin) sb_tile<true>(p0, p1, A, pw, kv0, qabs, hi, hsel); else sb_tile<false>(p0, p1, A, pw, kv0, qabs, hi, hsel);
            pv(o, vb0 + i * SLOTB, __builtin_bit_cast(bf16x8, pw[0]), __builtin_bit_cast(bf16x8, pw[1]), __builtin_bit_cast(bf16x8, pw[2]), __builtin_bit_cast(bf16x8, pw[3]));
        }
    }
    if (NT > 2) {
        f32x16 zc0, zc1; u32x4 pw[4];
#pragma unroll
        for (int k = 0; k < 4; ++k) pw[k] = (u32x4){0u, 0u, 0u, 0u};
        qkt(zc0, zc1, shm3 + 2 * SLOTB, qr, cin, r32, hi);
        int kcur = 2 * SLOTB, vcur = 2 * SLOTB, vprev = SLOTB;
#pragma nounroll
        for (int i = 2; i < NT; ++i) {
            P4_WAIT(i);
            if (i + 3 < NT) P4_DMA(i + 3, ks3, vs3);
            P4_ADV();
            const int knext = (i + 1 < NT) ? (kcur == (P4_RK - 1) * SLOTB ? 0 : kcur + SLOTB) : kcur;
            f32x16 zn0, zn1;
            qkt(zn0, zn1, shm3 + knext, qr, cin, r32, hi);
            pv(o, vb0 + vprev, __builtin_bit_cast(bf16x8, pw[0]), __builtin_bit_cast(bf16x8, pw[1]), __builtin_bit_cast(bf16x8, pw[2]), __builtin_bit_cast(bf16x8, pw[3]));
            sb_tile<false>(zc0, zc1, A, pw, 64 * (NT - 1 - i), qabs, hi, hsel);
            zc0 = zn0; zc1 = zn1; vprev = vcur; kcur = knext; vcur = vcur == (P4_RV - 1) * SLOTB ? 0 : vcur + SLOTB;
        }
        pv(o, vb0 + vprev, __builtin_bit_cast(bf16x8, pw[0]), __builtin_bit_cast(bf16x8, pw[1]), __builtin_bit_cast(bf16x8, pw[2]), __builtin_bit_cast(bf16x8, pw[3]));
    }
    asm volatile("s_waitcnt lgkmcnt(0)" ::: "memory");
    bar4(bcnt, btarget, lane);
    unsigned short* Ow = O + (rowbase + q0 + wid * 32) * PO + h * 64;
    { const int lane = fresh_lane(); const int r32 = lane & 31, hi = lane >> 5; __attribute__((address_space(3))) unsigned short* stg = (__attribute__((address_space(3))) unsigned short*)shm + wid * 2048;
#pragma unroll
        for (int r = 0; r < 16; ++r) { const int orow = crow(r, hi);
#pragma unroll
            for (int d0 = 0; d0 < 2; ++d0) stg[orow * 64 + d0 * 32 + r32] = (unsigned short)(cvtpk(o[d0][r], 0.f) & 0xffffu); }
        asm volatile("s_waitcnt lgkmcnt(0)" ::: "memory");
#pragma unroll
        for (int i = 0; i < 4; ++i) { const int row = i * 8 + (lane >> 3), ch = lane & 7; const u32x4 v = *(const __attribute__((address_space(3))) u32x4*)(stg + row * 64 + ch * 8); *(u32x4*)(Ow + (long)row * PO + ch * 8) = v; } }
    asm volatile("s_waitcnt lgkmcnt(0)" ::: "memory");
    bar4(bcnt, btarget, lane);
#undef P4_DMA
#undef P4_WAIT
#undef P4_ADV
}
#undef SBA_WAIT_BAR
}

namespace sbs {
using bf16x8 = __attribute__((ext_vector_type(8))) short;
using s16x4 = __attribute__((ext_vector_type(4))) short;
using f32x4 = __attribute__((ext_vector_type(4))) float;
using u32x2 = __attribute__((ext_vector_type(2))) unsigned;
using u32x4 = __attribute__((ext_vector_type(4))) unsigned;
#define SLAS __attribute__((address_space(3)))
constexpr int ROWB = 144, VT_BYTES = 32 * ROWB  , L_KT = 8 * VT_BYTES, L_COMB = 16 * VT_BYTES  , L_BYTES = L_COMB + 4 * 64 * 16 * 4, L_SOLO_BYTES = L_KT + 4 * VT_BYTES;
struct Regs { f32x4 k[8]; f32x4 v[8]; };
__device__ __forceinline__ unsigned pk(float a, float b) { return sba::cvtpk(a, b); }
__device__ __forceinline__ bf16x8 pack8(const f32x4 a, const f32x4 b) { u32x4 w = {pk(a[0], a[1]), pk(a[2], a[3]), pk(b[0], b[1]), pk(b[2], b[3])}; return __builtin_bit_cast(bf16x8, w); }
__device__ __forceinline__ void load_step(Regs& R, const float* kp, const float* vp, int s, int l15, int fq) {
    const float* kr = kp + (size_t)(32 * s + fq) * 512 + 4 * l15;
    const float* vr = vp + (size_t)(32 * s + fq) * 512 + 4 * l15;
#pragma unroll
    for (int u = 0; u < 8; ++u) R.k[u] = __builtin_nontemporal_load((const f32x4*)(kr + (size_t)u * 4 * 512));
#pragma unroll
    for (int u = 0; u < 8; ++u) R.v[u] = __builtin_nontemporal_load((const f32x4*)(vr + (size_t)u * 4 * 512));
}
__device__ __forceinline__ void sb16(f32x4& z, float& A, int fq, bool v0, bool v1, bool v2, bool v3) {
    float s[4] = {v0 ? sba::sp2(z[0]) : 0.f, v1 ? sba::sp2(z[1]) : 0.f, v2 ? sba::sp2(z[2]) : 0.f, v3 ? sba::sp2(z[3]) : 0.f};
    const float gs = (s[0] + s[1]) + (s[2] + s[3]);
    const auto a16 = __builtin_amdgcn_permlane16_swap(__float_as_uint(gs), __float_as_uint(gs), false, false);
    const auto e32 = __builtin_amdgcn_permlane32_swap(a16[0], a16[0], false, false);
    const auto o32 = __builtin_amdgcn_permlane32_swap(a16[1], a16[1], false, false);
    const float v0_ = __uint_as_float(e32[0]), v1_ = __uint_as_float(o32[0]), v2_ = __uint_as_float(e32[1]), v3_ = __uint_as_float(o32[1]);
    const float s2_ = v2_ + v3_, s1_ = v1_ + s2_;
    const float after = fq == 0 ? s1_ : (fq == 1 ? s2_ : (fq == 2 ? v3_ : 0.f));
    float c = A + after;
    c += s[3]; const float w3 = v3 ? __builtin_amdgcn_exp2f(z[3] - c) : 0.f;
    c += s[2]; const float w2 = v2 ? __builtin_amdgcn_exp2f(z[2] - c) : 0.f;
    c += s[1]; const float w1 = v1 ? __builtin_amdgcn_exp2f(z[1] - c) : 0.f;
    c += s[0]; const float w0 = v0 ? __builtin_amdgcn_exp2f(z[0] - c) : 0.f;
    z = (f32x4){w0, w1, w2, w3};
    A += v0_ + s1_;
}
__device__ __forceinline__ void pv_step(f32x4 (&O)[4], unsigned vt_rd, bf16x8 wb) {
    s16x4 lo[4], hi[4];
#pragma unroll
    for (int md = 0; md < 4; ++md) {
        asm volatile("ds_read_b64_tr_b16 %0,%1 offset:%c2" : "=&v"(lo[md]) : "v"(vt_rd), "i"(md * 32) : "memory");
        asm volatile("ds_read_b64_tr_b16 %0,%1 offset:%c2" : "=&v"(hi[md]) : "v"(vt_rd), "i"(md * 32 + 16 * ROWB) : "memory"); }
    asm volatile("s_waitcnt lgkmcnt(0)" ::: "memory"); __builtin_amdgcn_sched_barrier(0);
#pragma unroll
    for (int md = 0; md < 4; ++md) { const bf16x8 a = (bf16x8){lo[md][0], lo[md][1], lo[md][2], lo[md][3], hi[md][0], hi[md][1], hi[md][2], hi[md][3]};
        O[md] = __builtin_amdgcn_mfma_f32_16x16x32_bf16(a, wb, O[md], 0, 0, 0); }
}
__device__ __forceinline__ void consume_step(const Regs& R, bf16x8 (&kf)[4], SLAS unsigned char* kt, SLAS unsigned char* vt, unsigned vt_wr, unsigned kt_rd) {
#pragma unroll
    for (int u = 0; u < 8; ++u) { const u32x2 w = {pk(R.k[u][0], R.k[u][1]), pk(R.k[u][2], R.k[u][3])}; *(SLAS u32x2*)(kt + vt_wr + u * 4 * ROWB) = w; }
#pragma unroll
    for (int u = 0; u < 8; ++u) { const u32x2 w = {pk(R.v[u][0], R.v[u][1]), pk(R.v[u][2], R.v[u][3])}; *(SLAS u32x2*)(vt + vt_wr + u * 4 * ROWB) = w; }
#pragma unroll
    for (int g = 0; g < 2; ++g)
#pragma unroll
        for (int kk = 0; kk < 2; ++kk) kf[2 * g + kk] = *(const SLAS bf16x8*)(kt + kt_rd + g * 16 * ROWB + kk * 64);
}
__device__ __forceinline__ void math_step(const bf16x8 (&kf)[4], const bf16x8 (&qf)[2], const f32x4 cin, float& A, f32x4 (&O)[4], unsigned vt_rd, int fq) {
    f32x4 z[2];
#pragma unroll
    for (int g = 0; g < 2; ++g) { z[g] = __builtin_amdgcn_mfma_f32_16x16x32_bf16(kf[2 * g], qf[0], cin, 0, 0, 0);
        z[g] = __builtin_amdgcn_mfma_f32_16x16x32_bf16(kf[2 * g + 1], qf[1], z[g], 0, 0, 0); }
    sb16(z[1], A, fq, true, true, true, true);
    sb16(z[0], A, fq, true, true, true, true);
    pv_step(O, vt_rd, pack8(z[0], z[1]));
}
template <bool SOLO> __device__ __forceinline__ void unit(int b, int hg, const unsigned short* Q, const unsigned short* Kn, const unsigned short* Vn, const float* ck, const float* cv, const int* pt, const float* sbias,
                                     unsigned short* AB, SLAS unsigned char* shm, int wid) {
    const int lane = sba::fresh_lane(); const int l15 = lane & 15, fq = lane >> 4;
    const int h = 4 * hg + (wid & 3), half = SOLO ? 0 : (wid >> 2);
    constexpr int NSTEP = SOLO ? 64 : 32;
    const int row0 = 16384 + 8 * b;
    SLAS unsigned char* vt = shm + wid * VT_BYTES; SLAS unsigned char* kt = shm + L_KT + wid * VT_BYTES;
    const unsigned kt_rd = (unsigned)(l15 * ROWB + fq * 16);
    const unsigned vt_wr = (unsigned)(fq * ROWB + l15 * 8);
    const unsigned vt_rd = (unsigned)(uintptr_t)vt + (unsigned)((4 * fq + (l15 >> 2)) * ROWB + (l15 & 3) * 8);
    const float bias2 = sbias[h] * 1.4426950408889634f;
    const f32x4 cin = {bias2, bias2, bias2, bias2};
    bf16x8 qf[2];
#pragma unroll
    for (int kk = 0; kk < 2; ++kk) { u32x4 w = {0u, 0u, 0u, 0u};
        if (l15 < 8) w = *(const u32x4*)(Q + (size_t)(row0 + l15) * 512 + h * 64 + 32 * kk + 8 * fq);
        qf[kk] = __builtin_bit_cast(bf16x8, w); }
    float A = 0.f; f32x4 O[4];
#pragma unroll
    for (int md = 0; md < 4; ++md) O[md] = (f32x4){0.f, 0.f, 0.f, 0.f};
    const int pg_hi = half == 0 ? 15 : 7;
    const int ptv = pt[b * 16 + l15];
#define SBS_PAGE(pg) __builtin_amdgcn_readlane(ptv, (pg))
    Regs Ra, Rb;
    { const int page = SBS_PAGE(pg_hi); load_step(Ra, ck + (size_t)page * 65536 + h * 64, cv + (size_t)page * 65536 + h * 64, 3, l15, fq); }
    if (half == 0) {
        u32x4 ka[2];
#pragma unroll
        for (int kk = 0; kk < 2; ++kk) { ka[kk] = (u32x4){0u, 0u, 0u, 0u};
            if (l15 < 8) ka[kk] = *(const u32x4*)(Kn + (size_t)(row0 + l15) * 512 + h * 64 + 32 * kk + 8 * fq); }
#pragma unroll
        for (int u = 0; u < 8; ++u) { u32x2 w = {0u, 0u}; const int key = 4 * u + fq;
            if (key < 8) w = *(const u32x2*)(Vn + (size_t)(row0 + key) * 512 + h * 64 + 4 * l15);
            *(SLAS u32x2*)(vt + vt_wr + u * 4 * ROWB) = w; }
        f32x4 z = __builtin_amdgcn_mfma_f32_16x16x32_bf16(__builtin_bit_cast(bf16x8, ka[0]), qf[0], cin, 0, 0, 0);
        z = __builtin_amdgcn_mfma_f32_16x16x32_bf16(__builtin_bit_cast(bf16x8, ka[1]), qf[1], z, 0, 0, 0);
        const int k0 = 4 * fq;
        sb16(z, A, fq, k0 < 8 && k0 < l15, k0 + 1 < 8 && k0 + 1 < l15, k0 + 2 < 8 && k0 + 2 < l15, k0 + 3 < 8 && k0 + 3 < l15);
        asm volatile("s_waitcnt lgkmcnt(0)" ::: "memory");
        pv_step(O, vt_rd, pack8(z, (f32x4){0.f, 0.f, 0.f, 0.f}));
    }
    { const int page = SBS_PAGE(pg_hi); load_step(Rb, ck + (size_t)page * 65536 + h * 64, cv + (size_t)page * 65536 + h * 64, 2, l15, fq); }
    bf16x8 kf[4];
#pragma nounroll
    for (int it = 0; it < NSTEP; it += 2) {
        __builtin_amdgcn_sched_barrier(0);
        consume_step(Ra, kf, kt, vt, vt_wr, kt_rd);
        __builtin_amdgcn_sched_barrier(0);
        if (it + 2 < NSTEP) { const int n = it + 2; const int page = SBS_PAGE(pg_hi - (n >> 2)); load_step(Ra, ck + (size_t)page * 65536 + h * 64, cv + (size_t)page * 65536 + h * 64, 3 - (n & 3), l15, fq); }
        __builtin_amdgcn_sched_barrier(0);
        math_step(kf, qf, cin, A, O, vt_rd, fq);
        __builtin_amdgcn_sched_barrier(0);
        consume_step(Rb, kf, kt, vt, vt_wr, kt_rd);
        __builtin_amdgcn_sched_barrier(0);
        if (it + 3 < NSTEP) { const int n = it + 3; const int page = SBS_PAGE(pg_hi - (n >> 2)); load_step(Rb, ck + (size_t)page * 65536 + h * 64, cv + (size_t)page * 65536 + h * 64, 3 - (n & 3), l15, fq); }
        __builtin_amdgcn_sched_barrier(0);
        math_step(kf, qf, cin, A, O, vt_rd, fq);
        __builtin_amdgcn_sched_barrier(0);
    }
    if constexpr (SOLO) {
        if (l15 < 8) {
#pragma unroll
            for (int md = 0; md < 4; ++md) { const u32x2 w = {pk(O[md][0], O[md][1]), pk(O[md][2], O[md][3])};
                *(u32x2*)(AB + (size_t)(row0 + l15) * 1024 + 512 + h * 64 + 16 * md + 4 * fq) = w; } }
        asm volatile("s_waitcnt lgkmcnt(0)" ::: "memory");
    } else {
    SLAS f32x4* cb = (SLAS f32x4*)(shm + L_COMB) + ((wid & 3) * 64 + lane) * 4;
    if (half == 1) {
#pragma unroll
        for (int md = 0; md < 4; ++md) cb[md] = O[md]; }
    asm volatile("s_waitcnt vmcnt(0) lgkmcnt(0)" ::: "memory");
    __syncthreads();
    if (half == 0) {
        const float f = __builtin_amdgcn_exp2f(-A);
        if (l15 < 8) {
#pragma unroll
            for (int md = 0; md < 4; ++md) { const f32x4 o = O[md] + cb[md] * f; const u32x2 w = {pk(o[0], o[1]), pk(o[2], o[3])};
                *(u32x2*)(AB + (size_t)(row0 + l15) * 1024 + 512 + h * 64 + 16 * md + 4 * fq) = w; } }
    }
    asm volatile("s_waitcnt lgkmcnt(0)" ::: "memory");
    __syncthreads();
    }
}
#undef SBS_PAGE
#undef SLAS
}

namespace tg {
using bf16x8 = __attribute__((ext_vector_type(8))) short;
using f32x4 = __attribute__((ext_vector_type(4))) float;
#define TLAS __attribute__((address_space(3)))
constexpr int CSTR = 68, WBYTES = 64 * CSTR * 4, L_BYTES = 8 * WBYTES;
template <class Epi> __device__ __forceinline__ void tail_gemm(TLAS unsigned char* lds, const unsigned short* A, const unsigned short* Bt, const int K, const int n_colp, const Epi& E, const int wid, const int vcu, const int G) {
    const int lane = sba::fresh_lane(); const int l15 = lane & 15, fq = lane >> 4;
    const int kq = K >> 3, nks = kq >> 5, kw = wid * kq;
    for (int piece = vcu; piece < 16 * n_colp; piece += G) {
        const int rp = piece / n_colp, cp = piece - rp * n_colp, r0 = 16384 + 64 * rp;
        const unsigned short* ap = A + (size_t)(r0 + l15) * K + kw + 8 * fq;
        const unsigned short* bp[4];
#pragma unroll
        for (int ni = 0; ni < 4; ++ni) bp[ni] = Bt + (size_t)E.brow(cp, 16 * ni + l15) * K + kw + 8 * fq;
        f32x4 acc[4][4];
#pragma unroll
        for (int mi = 0; mi < 4; ++mi)
#pragma unroll
            for (int ni = 0; ni < 4; ++ni) acc[mi][ni] = (f32x4){0.f, 0.f, 0.f, 0.f};
#pragma nounroll
        for (int k0 = 0; k0 < nks; k0 += 4) {
            bf16x8 af[4][4], bfr[4][4];
#pragma unroll
            for (int ks = 0; ks < 4; ++ks) if (k0 + ks < nks) {
#pragma unroll
                for (int mi = 0; mi < 4; ++mi) af[ks][mi] = *(const bf16x8*)(ap + (size_t)mi * 16 * K + (k0 + ks) * 32);
#pragma unroll
                for (int ni = 0; ni < 4; ++ni) bfr[ks][ni] = *(const bf16x8*)(bp[ni] + (k0 + ks) * 32); }
#pragma unroll
            for (int ks = 0; ks < 4; ++ks) if (k0 + ks < nks) {
#pragma unroll
                for (int mi = 0; mi < 4; ++mi)
#pragma unroll
                    for (int ni = 0; ni < 4; ++ni) acc[mi][ni] = __builtin_amdgcn_mfma_f32_16x16x32_bf16(af[ks][mi], bfr[ks][ni], acc[mi][ni], 0, 0, 0); }
        }
#pragma unroll
        for (int mi = 0; mi < 4; ++mi)
#pragma unroll
            for (int ni = 0; ni < 4; ++ni) *(TLAS f32x4*)(lds + wid * WBYTES + ((16 * ni + l15) * CSTR + 4 * (4 * mi + fq)) * 4) = acc[mi][ni];
        __syncthreads();
        f32x4 s[2];
#pragma unroll
        for (int pass = 0; pass < 2; ++pass) { const int rq = wid + 8 * pass; s[pass] = (f32x4){0.f, 0.f, 0.f, 0.f};
#pragma unroll
            for (int w = 0; w < 8; ++w) s[pass] += *(const TLAS f32x4*)(lds + w * WBYTES + (lane * CSTR + 4 * rq) * 4); }
        E.piece(s, r0 + 4 * wid, cp, lane);
        __syncthreads();
    }
}
__device__ __forceinline__ float wsum(float v) {
#pragma unroll
    for (int o = 1; o < 64; o <<= 1) v += __shfl_xor(v, o);
    return v; }
__device__ __forceinline__ unsigned short f2bf16(float f) { return (unsigned short)(sba::cvtpk(f, 0.f) & 0xffffu); }
template <bool BASE_F32, bool RLO = true, bool WLO = true> struct TailRes {
    unsigned char* ws; const float* base_s  ;
    __device__ __forceinline__ int brow(int cp, int x) const { return 64 * cp + x; }
    __device__ __forceinline__ void piece(const f32x4 (&s)[2], int row0, int cp, int lane) const {
        unsigned short* HI = (unsigned short*)(ws + pg8::XWS_XN); unsigned short* LO = (unsigned short*)(ws + pg8::XWS_LO); float* stats = (float*)(ws + pg8::XWS_STATS);
        const int col = 64 * cp + lane;
        float x[8];
#pragma unroll
        for (int k = 0; k < 8; ++k) { const int row = row0 + 32 * (k >> 2) + (k & 3);
            if constexpr (BASE_F32) x[k] = base_s[(size_t)(row - 16384) * 1024 + col];
            else if constexpr (RLO) x[k] = __builtin_bit_cast(float, (unsigned)HI[(size_t)row * 1024 + col] << 16) + __builtin_bit_cast(float, (unsigned)LO[(size_t)row * 1024 + col] << 16);
            else x[k] = __builtin_bit_cast(float, (unsigned)HI[(size_t)row * 1024 + col] << 16); }
#pragma unroll
        for (int k = 0; k < 8; ++k) x[k] += s[k >> 2][k & 3];
#pragma unroll
        for (int k = 0; k < 8; ++k) { const int row = row0 + 32 * (k >> 2) + (k & 3);
            const unsigned short hi = f2bf16(x[k]); HI[(size_t)row * 1024 + col] = hi; if constexpr (WLO) LO[(size_t)row * 1024 + col] = f2bf16(x[k] - __builtin_bit_cast(float, (unsigned)hi << 16));
            const float ss = wsum(x[k] * x[k]);
            if (lane == 0) stats[(size_t)row * 16 + cp] = ss; }
    }
};
using TailRes0 = TailRes<true, false, false>; using TailResM = TailRes<false, false, false>; using TailResL = TailRes<false, false, true>;
struct TailInOdd {
    unsigned char* ws;
    __device__ __forceinline__ int brow(int cp, int x) const {
        if (cp < 8) return 64 * cp + x;
        if (cp < 24) { const int j = cp - 8, base = 512 + 256 * (j >> 2) + 32 * (j & 3); return x < 32 ? base + x : base + 128 + (x - 32); }
        return 1536 + 64 * (cp - 24) + x; }
    __device__ __forceinline__ void piece(const f32x4 (&s)[2], int row0, int cp, int lane) const {
        const float* stats = (const float*)(ws + pg8::XWS_STATS);
        unsigned short* GB = (unsigned short*)(ws + pg8::XWS_GLU); unsigned short* CX = (unsigned short*)(ws + pg8::XWS_Q); unsigned short* U = (unsigned short*)(ws + pg8::XWS_K);
        float st[8];
#pragma unroll
        for (int k = 0; k < 8; ++k) { const int row = row0 + 32 * (k >> 2) + (k & 3); st[k] = lane < 16 ? stats[(size_t)row * 16 + lane] : 0.f; }
#pragma unroll
        for (int k = 0; k < 8; ++k) { const int row = row0 + 32 * (k >> 2) + (k & 3);
            const float v = s[k >> 2][k & 3] * (1.0f / sqrtf(wsum(st[k]) * (1.0f / 1024.0f) + 1e-6f));
            if (cp < 8) GB[(size_t)row * 512 + 64 * cp + lane] = f2bf16(v);
            else if (cp < 24) { const float p = v * __shfl_xor(v, 32); if (lane < 32) CX[(size_t)row * 512 + 32 * (cp - 8) + lane] = f2bf16(p); }
            else U[(size_t)row * 512 + 64 * (cp - 24) + lane] = f2bf16(v); }
    }
};
#undef TLAS
}

struct Frame {
    LAS unsigned char* lds;
    volatile LAS unsigned* MISC;
    gu32* ctl;
    int wave;
    int vcu, G;
    __device__ __forceinline__ int lane_() const { int l; asm volatile("v_mbcnt_lo_u32_b32 %0, -1, 0\n\tv_mbcnt_hi_u32_b32 %0, -1, %0" : "=v"(l)); return l; }
    __device__ __forceinline__ int tid_() const { return wave * 64 + lane_(); }
};
struct Args { const void* in[25]; float* out; unsigned char* ws; int ph_lo, ph_hi; };
typedef const __attribute__((address_space(4))) Args CArgs;
__device__ __forceinline__ CArgs* argp() { CArgs* p = (CArgs*)__builtin_amdgcn_kernarg_segment_ptr(); asm volatile("" : "+s"(p)); return p; }

__device__ __forceinline__ float wave_sum(float v) {
#define WS_DPP(x, ctrl) __builtin_bit_cast(float, __builtin_amdgcn_update_dpp(0, __builtin_bit_cast(int, (x)), (ctrl), 0xf, 0xf, true))
    v += WS_DPP(v, 0xB1); v += WS_DPP(v, 0x4E); v += WS_DPP(v, 0x141); v += WS_DPP(v, 0x140);
#undef WS_DPP
    const int iv = __builtin_bit_cast(int, v);
    const float r0 = __builtin_bit_cast(float, __builtin_amdgcn_readlane(iv, 0)), r1 = __builtin_bit_cast(float, __builtin_amdgcn_readlane(iv, 16)), r2 = __builtin_bit_cast(float, __builtin_amdgcn_readlane(iv, 32)), r3 = __builtin_bit_cast(float, __builtin_amdgcn_readlane(iv, 48));
    return (r0 + r1) + (r2 + r3);
}
__device__ __forceinline__ int map_row(int mode, int n) {
    if (mode == 1) {
        if (n < 512) return (n >> 7) * 256 + (n & 127);
        if (n < 1024) { const int m = n - 512; return (m >> 7) * 256 + 128 + (m & 127); }
        return n;
    } else if (mode == 2) {
        if (n < 512) return n;
        if (n < 1024) { const int m = n - 512; return 512 + (m >> 7) * 256 + (m & 127); }
        if (n < 1536) { const int m = n - 1024; return 512 + (m >> 7) * 256 + 128 + (m & 127); }
        return n;
    } else if (mode == 3) {
        if (n < FFN) return (n >> 7) * 256 + (n & 127);
        const int m = n - FFN; return (m >> 7) * 256 + 128 + (m & 127);
    }
    return n;
}
__device__ __forceinline__ void p0_transpose_item(const float* W, int K, int N, bf16* WT, int mode, LAS float* scr, int item, int lane, const float* gk = nullptr) {
    const int nblk = N / 32, kb = item / nblk, nb = item % nblk, k0 = 64 * kb, n0 = 32 * nb;
    const int d0 = map_row(mode, n0);
    float wv[32];
#pragma unroll
    for (int i = 0; i < 32; ++i) wv[i] = __builtin_nontemporal_load(W + (size_t)(k0 + 2 * i + (lane >> 5)) * N + n0 + (lane & 31));
#pragma unroll
    for (int i = 0; i < 32; ++i) scr[(2 * i + (lane >> 5)) * 33 + (lane & 31)] = gk ? wv[i] * gk[k0 + 2 * i + (lane >> 5)] : wv[i];
    LDS_WAIT(); asm volatile("" ::: "memory");
    const int c = lane & 7;
#pragma unroll
    for (int j = 0; j < 4; ++j) { const int n = (lane >> 3) + 8 * j; const LAS float* s = scr + (8 * c) * 33 + n;
        v4u o; o.x = pk2(s[0 * 33], s[1 * 33]); o.y = pk2(s[2 * 33], s[3 * 33]); o.z = pk2(s[4 * 33], s[5 * 33]); o.w = pk2(s[6 * 33], s[7 * 33]);
        *(GAS v4u*)(WT + (size_t)(d0 + n) * K + k0 + 8 * c) = o; }
    LDS_WAIT(); asm volatile("" ::: "memory");
}
__device__ __forceinline__ void p0_fold_item(const float* pw, const float* psc, const float* wo, bf16* WT, LAS float* scr, int item, int lane) {
    const int g = item >> 8, cb = (item >> 4) & 15, nb = item & 15, n = nb * 64 + lane;
    const float* pwg = pw + ((size_t)g * 128 + cb * 8) * 128;
    { f32x4 pv[4];
#pragma unroll
      for (int k = 0; k < 4; ++k) pv[k] = *(const f32x4*)(pwg + 256 * k + 4 * lane);
      const f32x4 sc = *(const f32x4*)(psc + g * 128 + ((4 * lane) & 127));
#pragma unroll
      for (int k = 0; k < 4; ++k) *(LAS f32x4*)(scr + 256 * k + 4 * lane) = pv[k] * sc; }
    LDS_WAIT(); asm volatile("" ::: "memory");
    float acc[8];
#pragma unroll
    for (int i = 0; i < 8; ++i) acc[i] = 0.f;
    const float* wop = wo + (size_t)(512 + g * 128) * DM + n;
#pragma nounroll
    for (int h = 0; h < 4; ++h) {
        float w[32];
#pragma unroll
        for (int d = 0; d < 32; ++d) w[d] = wop[(size_t)(32 * h + d) * DM];
        const LAS float* sp = scr + 32 * h;
#pragma unroll
        for (int d4 = 0; d4 < 8; ++d4) {
#pragma unroll
            for (int i = 0; i < 8; ++i) { const f32x4 p = *(const LAS f32x4*)(sp + i * 128 + 4 * d4);
                acc[i] += (p[0] * w[4 * d4] + p[1] * w[4 * d4 + 1]) + (p[2] * w[4 * d4 + 2] + p[3] * w[4 * d4 + 3]); }
            __builtin_amdgcn_sched_barrier(0); } }
    v4u o; o.x = pk2(acc[0], acc[1]); o.y = pk2(acc[2], acc[3]); o.z = pk2(acc[4], acc[5]); o.w = pk2(acc[6], acc[7]);
    *(GAS v4u*)(WT + (size_t)n * DM + 512 + g * 128 + cb * 8) = o;
    LDS_WAIT(); asm volatile("" ::: "memory");
}
template <int SEG> __device__ __forceinline__ void p0_weights(Frame& F, CArgs& a, bool deferred, int rank, int nworkers) {
    const int lane = F.lane_();
    LAS float* scr = (LAS float*)(F.lds + RING_OFF + F.wave * 16384);
    unsigned char* ws = a.ws;
    constexpr int I_IE = 16 * (N_IN_E / 32), I_OUT = 16 * 32, I_IO = 16 * (N_IN_O / 32), I_FI = 16 * (N_FF / 32), I_FO = (FFN / 64) * 32, I_FOLD = 4 * 16 * 16;
    if constexpr (SEG == 0) {
        for (int it = rank; it < I_IE + I_IO + I_FOLD + I_FI; it += nworkers) { int r = it;
            if (r < I_IE) { p0_transpose_item((const float*)a.in[11], DM, N_IN_E, (bf16*)(ws + WS_WE_IN), 1, scr, r, lane, (const float*)a.in[8]); continue; } r -= I_IE;
            if (r < I_IO) { p0_transpose_item((const float*)a.in[18], DM, N_IN_O, (bf16*)(ws + WS_WO_IN), 2, scr, r, lane, (const float*)a.in[8] + DM); continue; } r -= I_IO;
            if (r < I_FOLD) { p0_fold_item((const float*)a.in[20], (const float*)a.in[21], (const float*)a.in[22], (bf16*)(ws + WS_WO_OUT), scr, r, lane); continue; } r -= I_FOLD;
            p0_transpose_item((const float*)a.in[23] + (size_t)DM * N_FF, DM, N_FF, (bf16*)(ws + WS_WF_IN + 11 * MiB), 3, scr, r, lane, (const float*)a.in[9] + DM); }
    }
    if (SEG == 1 || (SEG == 0 && !deferred)) {
        for (int it = rank; it < I_OUT + I_FI + I_OUT / 2; it += nworkers) { int r = it;
            if (r < I_OUT) { p0_transpose_item((const float*)a.in[17], DM, DM, (bf16*)(ws + WS_WE_OUT), 0, scr, r, lane); continue; } r -= I_OUT;
            if (r < I_FI) { p0_transpose_item((const float*)a.in[23], DM, N_FF, (bf16*)(ws + WS_WF_IN), 3, scr, r, lane, (const float*)a.in[9]); continue; } r -= I_FI;
            p0_transpose_item((const float*)a.in[22], DM, DM, (bf16*)(ws + WS_WO_OUT), 0, scr, r, lane); }
    }
    if (SEG == 2 || (SEG == 0 && !deferred)) {
        for (int r = rank; r < I_FO; r += nworkers) p0_transpose_item((const float*)a.in[24], FFN, DM, (bf16*)(ws + WS_WF_OUT), 0, scr, r, lane);
    }
    if (SEG == 3 || (SEG == 0 && !deferred)) {
        for (int r = rank; r < I_FO; r += nworkers) p0_transpose_item((const float*)a.in[24] + (size_t)FFN * DM, FFN, DM, (bf16*)(ws + WS_WF_OUT + 6 * MiB), 0, scr, r, lane);
    }
}
__device__ __forceinline__ void p0_prologue(Frame& F, CArgs& a, bool deferred) {
    const int lane = F.lane_();
    const int gw = F.vcu * NWAVES + F.wave, NGW = F.G * NWAVES;
    unsigned char* ws = a.ws;
    p0_weights<0>(F, a, deferred, gw, NGW);
    bf16* XN = (bf16*)(ws + WS_XN); float* stats = (float*)(ws + WS_STATS);
    static_assert(MT % 4 == 0 && MP % 4 == 0, "row quads");
    for (int m0 = 4 * gw; m0 < MT; m0 += 4 * NGW) {
        f32x4 v[4][4];
#pragma unroll
        for (int r = 0; r < 4; ++r) { const int m = m0 + r;
            const float* xrow = m < MP ? (const float*)a.in[0] + (size_t)m * DM : (const float*)a.in[1] + (size_t)(m - MP) * DM;
#pragma unroll
            for (int j = 0; j < 4; ++j) v[r][j] = __builtin_nontemporal_load((const f32x4*)xrow + lane + 64 * j); }
#pragma unroll
        for (int r = 0; r < 4; ++r) { const int m = m0 + r; float s = 0.f;
#pragma unroll
            for (int j = 0; j < 4; ++j) s += (v[r][j].x * v[r][j].x + v[r][j].y * v[r][j].y) + (v[r][j].z * v[r][j].z + v[r][j].w * v[r][j].w);
            s = wave_sum(s);
            GAS unsigned long long* o8 = (GAS unsigned long long*)(XN + (size_t)m * DM) + lane;
#pragma unroll
            for (int j = 0; j < 4; ++j) { const f32x4 y = v[r][j]; o8[64 * j] = (unsigned long long)pk2h(y.x, y.y) | ((unsigned long long)pk2h(y.z, y.w) << 32); }
            if (lane < 16) stats[(size_t)m * 16 + lane] = lane == 0 ? s : 0.f; }
    }
}

constexpr int CONV_PA = 3;
__device__ __forceinline__ void conv_phase(Frame& F, CArgs& a) {
    const int lane = F.lane_(); const int half = F.wave >> 2, cp = (F.wave & 3) * 64 + lane, c0 = 2 * cp;
    const float* cw = (const float*)a.in[12]; const float* st = (const float*)a.in[4];
    const bf16* GLU = (const bf16*)(a.ws + WS_GLU); bf16* AB = (bf16*)(a.ws + WS_AB);
    float* conv_p = a.out + O_CONVP; float* conv_s = a.out + O_CONVS;
    f32x2 wv[CW];
#pragma unroll
    for (int t = 0; t < CW; ++t) wv[t] = *(const f32x2*)(cw + t * 512 + c0);
    const f32x2 cb = *(const f32x2*)((const float*)a.in[13] + c0), lg = *(const f32x2*)((const float*)a.in[14] + c0), lb = *(const f32x2*)((const float*)a.in[15] + c0);
    LAS float* red = (LAS float*)(F.lds + RING_OFF);
    int it_par = 0;
#define SLOT(i) (i)
    unsigned raw[38];
#define CONV_FETCH(gg) do { const int seq_ = (gg) >> 8, t0_ = ((gg) & 255) * 8; _Pragma("unroll") for (int i = 0; i < 38; ++i) { const int t = t0_ - 30 + i; \
        raw[i] = *(const unsigned*)(GLU + (size_t)(seq_ * SEQ + (t < 0 ? 0 : t)) * 512 + c0); } } while (0)
    { const int g0 = 2 * F.vcu + half; if (g0 < MP / 8) CONV_FETCH(g0); }
    for (int pair = F.vcu; pair < CONV_PA * F.G; pair += F.G) {
        const int g = 2 * pair + half;
        f32x2 xv[38]; int row0;
        if (g < MP / 8) {
            const int seq = g >> 8, t0 = (g & 255) * 8; row0 = seq * SEQ + t0;
#pragma unroll
            for (int i = 0; i < 38; ++i) xv[i] = (f32x2){bflo(raw[i]), bfhi(raw[i])};
            if (t0 < 30) {
#pragma unroll
                for (int i = 0; i < 30; ++i) if (t0 - 30 + i < 0) xv[i] = (f32x2){0.f, 0.f}; }
            { const int gn = g + 2 * F.G; if (pair + F.G < CONV_PA * F.G && gn < MP / 8) CONV_FETCH(gn); }
#pragma unroll
            for (int j = 0; j < 8; ++j) { const int t = t0 + j; if (t >= SEQ - 30) *(f32x2*)(conv_p + ((size_t)seq * 30 + (t - (SEQ - 30))) * 512 + c0) = xv[30 + j]; }
        } else {
            const int b = g - MP / 8; row0 = MP + b * 8;
#pragma unroll
            for (int i = 0; i < 30; ++i) xv[i] = *(const f32x2*)(st + ((size_t)b * 30 + i) * 512 + c0);
#pragma unroll
            for (int i = 30; i < 38; ++i) { const unsigned v = *(const unsigned*)(GLU + (size_t)(row0 + i - 30) * 512 + c0); xv[i] = (f32x2){bflo(v), bfhi(v)}; }
#pragma unroll
            for (int i = 8; i < 38; ++i) *(f32x2*)(conv_s + ((size_t)b * 30 + (i - 8)) * 512 + c0) = xv[i];
        }
        f32x2 av[8]; float sv[16];
#pragma unroll
        for (int j = 0; j < 8; ++j) { f32x2 s = cb;
#pragma unroll
            for (int t = 0; t < CW; ++t) s = __builtin_elementwise_fma(wv[t], xv[j + t], s);
            av[j] = s; sv[2 * j] = s.x + s.y; sv[2 * j + 1] = s.x * s.x + s.y * s.y; }
#pragma unroll
        for (int k = 0; k < 8; ++k) { const bool up = (lane & 1) != 0; const float mine = up ? sv[2 * k + 1] : sv[2 * k], other = up ? sv[2 * k] : sv[2 * k + 1]; sv[k] = mine + __shfl_xor(other, 1); }
#pragma unroll
        for (int k = 0; k < 4; ++k) { const bool up = (lane & 2) != 0; const float mine = up ? sv[2 * k + 1] : sv[2 * k], other = up ? sv[2 * k] : sv[2 * k + 1]; sv[k] = mine + __shfl_xor(other, 2); }
#pragma unroll
        for (int k = 0; k < 2; ++k) { const bool up = (lane & 4) != 0; const float mine = up ? sv[2 * k + 1] : sv[2 * k], other = up ? sv[2 * k] : sv[2 * k + 1]; sv[k] = mine + __shfl_xor(other, 4); }
        { const bool up = (lane & 8) != 0; const float mine = up ? sv[1] : sv[0], other = up ? sv[0] : sv[1]; sv[0] = mine + __shfl_xor(other, 8); }
        float tot = sv[0]; tot += __shfl_xor(tot, 16); tot += __shfl_xor(tot, 32);
        LAS float* redb = red + (it_par & 1) * 128;
        if (lane < 16) redb[(half * 4 + (F.wave & 3)) * 16 + lane] = tot;
        __syncthreads();
        f32x4 st4[4];
#pragma unroll
        for (int k = 0; k < 4; ++k) { const LAS f32x4* rp = (const LAS f32x4*)(redb + half * 64) + k; st4[k] = (rp[0] + rp[4]) + (rp[8] + rp[12]); }
#pragma unroll
        for (int j = 0; j < 8; ++j) {
            const float s = st4[(2 * j) >> 2][(2 * j) & 3], q = st4[(2 * j + 1) >> 2][(2 * j + 1) & 3];
            const float mu = s * (1.f / 512.f), var = fmaxf(q * (1.f / 512.f) - mu * mu, 0.f), rstd = __builtin_amdgcn_rsqf(var + EPS);
            const f32x2 y = (av[j] - mu) * (lg * rstd) + lb;
            const f32x2 t = y * -LOG2E; const f32x2 e = {ex2(t.x), ex2(t.y)}; const f32x2 d = e + 1.0f;
            const f32x2 o = y * (f32x2){__builtin_amdgcn_rcpf(d.x), __builtin_amdgcn_rcpf(d.y)};
            *(unsigned*)(AB + (size_t)(row0 + j) * DM + c0) = sba::cvtpk(o.x, o.y);
        }
        ++it_par;
    }
#undef SLOT
#undef CONV_FETCH
}
__device__ __forceinline__ void conv_role4(Frame& F, CArgs& a, LAS unsigned* bcnt, unsigned& btarget) {
    const int lane = F.lane_(); const int cp = (F.wave & 3) * 64 + lane, c0 = 2 * cp;
    const float* cw = (const float*)a.in[12]; const float* st = (const float*)a.in[4];
    const bf16* GLU = (const bf16*)(a.ws + WS_GLU); bf16* AB = (bf16*)(a.ws + WS_AB);
    float* conv_p = a.out + O_CONVP; float* conv_s = a.out + O_CONVS;
    f32x2 wv[CW];
#pragma unroll
    for (int t = 0; t < CW; ++t) wv[t] = *(const f32x2*)(cw + t * 512 + c0);
    const f32x2 cb = *(const f32x2*)((const float*)a.in[13] + c0), lg = *(const f32x2*)((const float*)a.in[14] + c0), lb = *(const f32x2*)((const float*)a.in[15] + c0);
    LAS float* red = (LAS float*)(F.lds + RING_OFF);
    int it_par = 0;
#define SLOT(i) (i)
    unsigned raw[38];
#define CONV_FETCH(gg) do { const int seq_ = (gg) >> 8, t0_ = ((gg) & 255) * 8; _Pragma("unroll") for (int i = 0; i < 38; ++i) { const int t = t0_ - 30 + i; \
        raw[i] = *(const unsigned*)(GLU + (size_t)(seq_ * SEQ + (t < 0 ? 0 : t)) * 512 + c0); } } while (0)
    { const int g0 = 2 * CONV_PA * F.G + F.vcu; if (g0 < MP / 8) CONV_FETCH(g0); }
    for (int g = 2 * CONV_PA * F.G + F.vcu; g < MT / 8; g += F.G) {
        f32x2 xv[38]; int row0;
        if (g < MP / 8) {
            const int seq = g >> 8, t0 = (g & 255) * 8; row0 = seq * SEQ + t0;
#pragma unroll
            for (int i = 0; i < 38; ++i) xv[i] = (f32x2){bflo(raw[i]), bfhi(raw[i])};
            if (t0 < 30) {
#pragma unroll
                for (int i = 0; i < 30; ++i) if (t0 - 30 + i < 0) xv[i] = (f32x2){0.f, 0.f}; }
            { const int gn = g + F.G; if (gn < MP / 8) CONV_FETCH(gn); }
#pragma unroll
            for (int j = 0; j < 8; ++j) { const int t = t0 + j; if (t >= SEQ - 30) *(f32x2*)(conv_p + ((size_t)seq * 30 + (t - (SEQ - 30))) * 512 + c0) = xv[30 + j]; }
        } else {
            const int b = g - MP / 8; row0 = MP + b * 8;
#pragma unroll
            for (int i = 0; i < 30; ++i) xv[i] = *(const f32x2*)(st + ((size_t)b * 30 + i) * 512 + c0);
#pragma unroll
            for (int i = 30; i < 38; ++i) { const unsigned v = *(const unsigned*)(GLU + (size_t)(row0 + i - 30) * 512 + c0); xv[i] = (f32x2){bflo(v), bfhi(v)}; }
#pragma unroll
            for (int i = 8; i < 38; ++i) *(f32x2*)(conv_s + ((size_t)b * 30 + (i - 8)) * 512 + c0) = xv[i];
        }
        f32x2 av[8]; float sv[16];
#pragma unroll
        for (int j = 0; j < 8; ++j) { f32x2 s = cb;
#pragma unroll
            for (int t = 0; t < CW; ++t) s = __builtin_elementwise_fma(wv[t], xv[j + t], s);
            av[j] = s; sv[2 * j] = s.x + s.y; sv[2 * j + 1] = s.x * s.x + s.y * s.y; }
#pragma unroll
        for (int k = 0; k < 8; ++k) { const bool up = (lane & 1) != 0; const float mine = up ? sv[2 * k + 1] : sv[2 * k], other = up ? sv[2 * k] : sv[2 * k + 1]; sv[k] = mine + __shfl_xor(other, 1); }
#pragma unroll
        for (int k = 0; k < 4; ++k) { const bool up = (lane & 2) != 0; const float mine = up ? sv[2 * k + 1] : sv[2 * k], other = up ? sv[2 * k] : sv[2 * k + 1]; sv[k] = mine + __shfl_xor(other, 2); }
#pragma unroll
        for (int k = 0; k < 2; ++k) { const bool up = (lane & 4) != 0; const float mine = up ? sv[2 * k + 1] : sv[2 * k], other = up ? sv[2 * k] : sv[2 * k + 1]; sv[k] = mine + __shfl_xor(other, 4); }
        { const bool up = (lane & 8) != 0; const float mine = up ? sv[1] : sv[0], other = up ? sv[0] : sv[1]; sv[0] = mine + __shfl_xor(other, 8); }
        float tot = sv[0]; tot += __shfl_xor(tot, 16); tot += __shfl_xor(tot, 32);
        LAS float* redb = red + (it_par & 1) * 64;
        if (lane < 16) redb[(F.wave & 3) * 16 + lane] = tot;
        sba::bar4(bcnt, btarget, lane);
        f32x4 st4[4];
#pragma unroll
        for (int k = 0; k < 4; ++k) { const LAS f32x4* rp = (const LAS f32x4*)redb + k; st4[k] = (rp[0] + rp[4]) + (rp[8] + rp[12]); }
#pragma unroll
        for (int j = 0; j < 8; ++j) {
            const float s = st4[(2 * j) >> 2][(2 * j) & 3], q = st4[(2 * j + 1) >> 2][(2 * j + 1) & 3];
            const float mu = s * (1.f / 512.f), var = fmaxf(q * (1.f / 512.f) - mu * mu, 0.f), rstd = __builtin_amdgcn_rsqf(var + EPS);
            const f32x2 y = (av[j] - mu) * (lg * rstd) + lb;
            const f32x2 t = y * -LOG2E; const f32x2 e = {ex2(t.x), ex2(t.y)}; const f32x2 d = e + 1.0f;
            const f32x2 o = y * (f32x2){__builtin_amdgcn_rcpf(d.x), __builtin_amdgcn_rcpf(d.y)};
            *(unsigned*)(AB + (size_t)(row0 + j) * DM + c0) = sba::cvtpk(o.x, o.y);
        }
        ++it_par;
    }
#undef SLOT
#undef CONV_FETCH
}

constexpr int ATT_P_LDS = sba::P4_BYTES;
static_assert(ATT_P_LDS + sbs::L_SOLO_BYTES <= RING_BYTES, "attention LDS map");
__device__ __forceinline__ void attn_dual_phase(Frame& F) {
    if (F.tid_() == 0) *(LAS unsigned*)(F.lds + RING_OFF + sba::P4_BAR) = 0u;
    __syncthreads();
    if (F.wave < 4) {
        CArgs& a = *argp();
        const unsigned short* Q = (const unsigned short*)(a.ws + WS_Q); const unsigned short* Kb = (const unsigned short*)(a.ws + WS_K); const unsigned short* Vb = (const unsigned short*)(a.ws + WS_V);
        unsigned btarget = 0u;
        unsigned short* O = (unsigned short*)(a.ws + WS_AB) + 512;
        for (int p = F.vcu; p < NB * NH * 8; p += F.G) {
            const int bh = p >> 3, s = p & 7, b = bh >> 3, h = bh & 7;
            const float bias2 = ((const float*)a.in[16])[h] * LOG2E;
#pragma nounroll
            for (int k = 0; k < 2; ++k) sba::unitP4(b, h, k ? 15 - s : s, Q, Kb, Vb, O, bias2, F.lds + RING_OFF, F.wave, btarget);
        }
        conv_role4(F, a, (LAS unsigned*)(F.lds + RING_OFF + sba::P4_BAR), btarget);
    } else {
        CArgs& a = *argp();
        for (int p = F.vcu; p < NDB * 2; p += F.G)
            sbs::unit<true>(p >> 1, p & 1, (const unsigned short*)(a.ws + WS_Q), (const unsigned short*)(a.ws + WS_K), (const unsigned short*)(a.ws + WS_V), (const float*)a.in[2], (const float*)a.in[3], (const int*)a.in[7], (const float*)a.in[16],
                            (unsigned short*)(a.ws + WS_AB), F.lds + RING_OFF + ATT_P_LDS, F.wave - 4);
    }
    __syncthreads();
}
template <int W> __device__ __forceinline__ void pool8(const float (&e0)[23], const float (&e1)[23], bf16* CDrow0, bool prompt, int ts) {
#pragma unroll
    for (int j = 0; j < 8; ++j) { float s0 = 0.f, s1 = 0.f;
#pragma unroll
        for (int i = 0; i < W; ++i) { s0 += e0[15 + j - i]; s1 += e1[15 + j - i]; }
        int cnt = W; if (prompt && ts + j + 1 < W) cnt = ts + j + 1;
        const float inv = 1.0f / (float)cnt;
        *(unsigned*)(CDrow0 + (size_t)j * DM) = pk2h(s0 * inv - e0[15 + j], s1 * inv - e1[15 + j]); }
}
__device__ __forceinline__ void mix_odd_phase(Frame& F, CArgs& a) {
    const int half = F.wave >> 2, cp = (F.wave & 3) * 64 + F.lane_(), c0 = 2 * cp, gi = c0 >> 7;
    const bf16* GB = (const bf16*)(a.ws + WS_GB); const bf16* CX = (const bf16*)(a.ws + WS_CX); const bf16* U = (const bf16*)(a.ws + WS_U); bf16* CD = (bf16*)(a.ws + WS_CDD);
    const float* st_sc = (const float*)a.in[5]; const float* st_pl = (const float*)a.in[6]; const float* ccw = (const float*)a.in[19];
    float* sc_p = a.out + O_SCP; float* sc_s = a.out + O_SCS; float* pool_p = a.out + O_POOLP; float* pool_s = a.out + O_POOLS;
    const f32x2 cw0 = *(const f32x2*)(ccw + c0), cw1 = *(const f32x2*)(ccw + 512 + c0), cw2 = *(const f32x2*)(ccw + 1024 + c0);
    for (int pair = F.vcu; pair < (MT / 8) / 2; pair += F.G) {
        const int g = 2 * pair + half; const bool prompt = g < MP / 8;
        int rowbase, ts, b = 0, seq = 0;
        if (prompt) { seq = g >> 8; ts = (g & 255) * 8; rowbase = seq * SEQ; } else { b = g - MP / 8; rowbase = MP + b * 8; ts = 0; }
        float e0[23], e1[23], x0[10], x1[10];
        if (prompt) {
#pragma unroll
            for (int i = 0; i < 23; ++i) { const int t = ts - 15 + i; unsigned w = __builtin_nontemporal_load((const unsigned*)(U + (size_t)(rowbase + (t < 0 ? 0 : t)) * 512 + c0)); w = t < 0 ? 0u : w; e0[i] = bflo(w); e1[i] = bfhi(w); }
#pragma unroll
            for (int i = 0; i < 10; ++i) { const int t = ts - 2 + i; unsigned w = __builtin_nontemporal_load((const unsigned*)(CX + (size_t)(rowbase + (t < 0 ? 0 : t)) * 512 + c0)); w = t < 0 ? 0u : w; x0[i] = bflo(w); x1[i] = bfhi(w); }
        } else {
#pragma unroll
            for (int i = 0; i < 15; ++i) { const f32x2 w = *(const f32x2*)(st_pl + ((size_t)b * 15 + i) * 512 + c0); e0[i] = w.x; e1[i] = w.y; }
#pragma unroll
            for (int i = 15; i < 23; ++i) { const unsigned w = *(const unsigned*)(U + (size_t)(rowbase + i - 15) * 512 + c0); e0[i] = bflo(w); e1[i] = bfhi(w); }
#pragma unroll
            for (int i = 0; i < 2; ++i) { const f32x2 w = *(const f32x2*)(st_sc + ((size_t)b * 2 + i) * 512 + c0); x0[i] = w.x; x1[i] = w.y; }
#pragma unroll
            for (int i = 2; i < 10; ++i) { const unsigned w = *(const unsigned*)(CX + (size_t)(rowbase + i - 2) * 512 + c0); x0[i] = bflo(w); x1[i] = bfhi(w); }
        }
        bf16* CDr = CD + (size_t)(rowbase + ts) * DM;
        unsigned gw[8];
#pragma unroll
        for (int j = 0; j < 8; ++j) gw[j] = __builtin_nontemporal_load((const unsigned*)(GB + (size_t)(rowbase + ts + j) * 512 + c0));
#pragma unroll
        for (int j = 0; j < 8; ++j)
            *(unsigned*)(CDr + (size_t)j * DM + c0) = pk2h(bflo(gw[j]) * (cw0.x * x0[j] + cw1.x * x0[j + 1] + cw2.x * x0[j + 2]), bfhi(gw[j]) * (cw0.y * x1[j] + cw1.y * x1[j + 1] + cw2.y * x1[j + 2]));
        bf16* CDp = CDr + 512 + c0;
        if (gi == 0) pool8<2>(e0, e1, CDp, prompt, ts); else if (gi == 1) pool8<4>(e0, e1, CDp, prompt, ts); else if (gi == 2) pool8<8>(e0, e1, CDp, prompt, ts); else pool8<16>(e0, e1, CDp, prompt, ts);
        if (prompt) {
            if (ts + 7 >= SEQ - 15) {
#pragma unroll
                for (int j = 0; j < 8; ++j) { const int t = ts + j;
                    if (t >= SEQ - 15) *(f32x2*)(pool_p + ((size_t)seq * 15 + t - (SEQ - 15)) * 512 + c0) = (f32x2){e0[15 + j], e1[15 + j]};
                    if (t >= SEQ - 2) *(f32x2*)(sc_p + ((size_t)seq * 2 + t - (SEQ - 2)) * 512 + c0) = (f32x2){x0[2 + j], x1[2 + j]}; } }
        } else {
#pragma unroll
            for (int i = 0; i < 15; ++i) *(f32x2*)(pool_s + ((size_t)b * 15 + i) * 512 + c0) = (f32x2){e0[8 + i], e1[8 + i]};
            *(f32x2*)(sc_s + ((size_t)b * 2 + 0) * 512 + c0) = (f32x2){x0[8], x1[8]}; *(f32x2*)(sc_s + ((size_t)b * 2 + 1) * 512 + c0) = (f32x2){x0[9], x1[9]};
        }
    }
}
__device__ __forceinline__ void final_norm_phase(Frame& F, CArgs& a) {
    const int lane = F.lane_();
    const int gw = F.vcu * NWAVES + F.wave, NGW = F.G * NWAVES;
    const float* gf = (const float*)a.in[10]; const float* stats = (const float*)(a.ws + WS_STATS);
    const bf16* HI = (const bf16*)(a.ws + WS_XN);
    f32x4 gv[4];
#pragma unroll
    for (int j = 0; j < 4; ++j) gv[j] = *((const f32x4*)gf + lane + 64 * j);
    for (int m0 = gw; m0 < MT; m0 += 3 * NGW) {
        v2u h[3][4]; float s[3];
#pragma unroll
        for (int u = 0; u < 3; ++u) { const int m = (m0 + u * NGW) < MT ? (m0 + u * NGW) : m0;
            s[u] = stats[(size_t)m * 16 + (lane & 15)];
            const v2u* hr = (const v2u*)(HI + (size_t)m * DM) + lane;
#pragma unroll
            for (int j = 0; j < 4; ++j) h[u][j] = __builtin_nontemporal_load(hr + 64 * j); }
#pragma unroll
        for (int u = 0; u < 3; ++u) { const int m = m0 + u * NGW;
            float t = s[u]; t += __shfl_xor(t, 1); t += __shfl_xor(t, 2); t += __shfl_xor(t, 4); t += __shfl_xor(t, 8);
            const float r = 1.0f / sqrtf(t * (1.f / 1024.f) + EPS);
            if (m < MT) { f32x4* yr = (f32x4*)(a.out + (size_t)m * DM) + lane;
#pragma unroll
                for (int j = 0; j < 4; ++j) { const f32x4 x = {bflo(h[u][j].x), bfhi(h[u][j].x), bflo(h[u][j].y), bfhi(h[u][j].y)}; yr[64 * j] = x * r * gv[j]; } } }
    }
}

#ifndef MK_PER_PHASE
#define MK_PER_PHASE 0
#endif
constexpr int N_PHASES = 12;
__global__ void __launch_bounds__(NWAVES * 64, 2) mk_fwd(Args args) {
    extern __shared__ __attribute__((aligned(16))) unsigned char lds[];
    Frame F;
    F.lds = (LAS unsigned char*)lds;
    F.MISC = (volatile LAS unsigned*)(F.lds + MISC_OFF);
    F.wave = __builtin_amdgcn_readfirstlane((int)threadIdx.x >> 6);
    F.G = gridDim.x; { const int bx = blockIdx.x; F.vcu = (F.G % 8 == 0) ? (bx % 8) * (F.G / 8) + bx / 8 : bx; }
#define ARGP() argp()
    F.ctl = (gu32*)(ARGP()->ws + WS_CTL);
    for (int u = F.tid_(); u < (LDS_BYTES - LDSCTL_OFF) / 4; u += NWAVES * 64) ((LAS unsigned*)(F.lds + LDSCTL_OFF))[u] = 0u;
    __syncthreads();
    XcdBarrier bar; bar.bar = (unsigned*)(F.ctl + CW_BAR); bar.x = 0; bar.st = nullptr; bar.wv = F.wave;
    if (!MK_PER_PHASE) bar = xcd_barrier_post((unsigned*)(F.ctl + CW_BAR), F.MISC + 8, F.wave);
    const int lo = ARGP()->ph_lo, hi = ARGP()->ph_hi;
    constexpr int IDLE1 = (MT / 256) * (N_IN_E / 256) - 2 * 256, IDLE4 = (MT / 256) * (N_FF / 256) - 5 * 256;
    const bool defer_w = (F.G == 256) && lo == 0 && hi == N_PHASES;
#define IN(k) (lo <= (k) && (k) < hi)
#define SEAM(k) do { if (IN(k) && IN((k) + 1)) xcd_barrier(bar); } while (0)
#define TAIL_PHASE(EPI, Aoff, Boff, KK, NCP, ...) do { CArgs* A_ = ARGP(); unsigned char* ws = A_->ws; (void)ws; static_assert(tg::L_BYTES <= RING_BYTES, "tail LDS"); \
        tg::EPI E{__VA_ARGS__}; tg::tail_gemm<tg::EPI>(F.lds + RING_OFF, (const unsigned short*)(ws + (Aoff)), (const unsigned short*)(ws + (Boff)), (KK), (NCP), E, F.wave, F.vcu, F.G); } while (0)
#define GEMM_PHASE(EPI, MM, Aoff, Boff, NN, KK, ...) do { CArgs* A_ = ARGP(); unsigned char* ws = A_->ws; (void)ws; \
        pg8::Gemm g{(const bf16*)(ws + (Aoff)), (const bf16*)(ws + (Boff)), (MM), (NN), (KK)}; pg8::StaticOrder S; S.init((MM), (NN), F.G, (int)blockIdx.x); \
        pg8::EPI E{__VA_ARGS__}; if constexpr (pg8::EPI::ROWSCALE) pg8::prefetch_rowscale(F.lds + RING_OFF, (const float*)(ws + WS_STATS), S, F.tid_(), F.wave); \
        pg8::gemm_phase<pg8::EPI, pg8::StaticOrder, true, true>(F.lds + RING_OFF, g, S, E, F.wave); } while (0)
#define GEMM_PHASE_SLAB2(EPI, Aoff, Boff, NN, KK, ...) do { CArgs* A_ = ARGP(); unsigned char* ws = A_->ws; (void)ws; static_assert(MP / 256 * 16 == MS && pg8::EPI::ROWSCALE && MP / 256 * ((NN) / 256) <= 4 * 256, "slab"); \
        pg8::Gemm g{(const bf16*)(ws + (Aoff)), (const bf16*)(ws + (Boff)), MP, (NN), (KK)}; pg8::StaticOrder S; S.init(MP, (NN), F.G, (int)blockIdx.x); \
        pg8::EPI E{__VA_ARGS__}; pg8::prefetch_rowscale(F.lds + RING_OFF, (const float*)(ws + WS_STATS), S, F.tid_(), F.wave); \
        pg8::gemm_phase<pg8::EPI, pg8::StaticOrder, true, true, 2>(F.lds + RING_OFF, g, S, E, F.wave); } while (0)
#define GEMM_PHASE_SLAB(EPI, Aoff, Boff, KK, ...) do { CArgs* A_ = ARGP(); unsigned char* ws = A_->ws; (void)ws; static_assert(MP / 256 * 16 == MS && !pg8::EPI::ROWSCALE, "slab"); \
        pg8::Gemm g{(const bf16*)(ws + (Aoff)), (const bf16*)(ws + (Boff)), MP, DM, (KK)}; pg8::StaticOrder S; S.init(MP, DM, F.G, (int)blockIdx.x); \
        pg8::EPI E{__VA_ARGS__}; pg8::gemm_phase<pg8::EPI, pg8::StaticOrder, true, true, 1>(F.lds + RING_OFF, g, S, E, F.wave); } while (0)

    if (IN(0)) {
#ifndef NO_P0
        p0_prologue(F, *ARGP(), defer_w);
#endif
    } SEAM(0);
    if (IN(1)) { GEMM_PHASE(EpiInEven, MT, WS_XN, WS_WE_IN, N_IN_E, DM, ws, A_->out, F.lds + RING_OFF);
        if (defer_w && (int)blockIdx.x >= IDLE1) p0_weights<1>(F, *ARGP(), true, ((int)blockIdx.x - IDLE1) * NWAVES + F.wave, (256 - IDLE1) * NWAVES); } SEAM(1);
    if (IN(2)) {
#ifndef NO_CONV
        conv_phase(F, *ARGP());
        __syncthreads();
#endif
#ifndef NO_ATTN
        attn_dual_phase(F);
#endif
    } SEAM(2);
    if (IN(3)) GEMM_PHASE_SLAB(EpiResM, WS_AB, WS_WE_OUT, DM, ws, (const float*)nullptr, (const float*)nullptr); SEAM(3);
    if (IN(4)) { GEMM_PHASE(EpiFfn, MT, WS_XN, WS_WF_IN, N_FF, DM, ws, F.lds + RING_OFF);
        if (defer_w && (int)blockIdx.x >= IDLE4) p0_weights<2>(F, *ARGP(), true, ((int)blockIdx.x - IDLE4) * NWAVES + F.wave, (256 - IDLE4) * NWAVES); } SEAM(4);
    if (IN(5)) GEMM_PHASE_SLAB(EpiResM, WS_ACT, WS_WF_OUT, FFN, ws, (const float*)nullptr, (const float*)nullptr); SEAM(5);
    if (IN(6)) GEMM_PHASE_SLAB2(EpiInOdd, WS_XN, WS_WO_IN, N_IN_O, DM, ws, F.lds + RING_OFF); SEAM(6);
    if (IN(7)) {
#ifndef NO_ODD
        mix_odd_phase(F, *ARGP());
#endif
    } SEAM(7);
    if (IN(8)) GEMM_PHASE_SLAB(EpiResM, WS_CDD, WS_WO_OUT, DM, ws, (const float*)nullptr, (const float*)nullptr); SEAM(8);
    if (IN(9)) { GEMM_PHASE(EpiFfn, MT, WS_XN, WS_WF_IN + 11 * MiB, N_FF, DM, ws, F.lds + RING_OFF);
        if (defer_w && (int)blockIdx.x >= IDLE4) p0_weights<3>(F, *ARGP(), true, ((int)blockIdx.x - IDLE4) * NWAVES + F.wave, (256 - IDLE4) * NWAVES); } SEAM(9);
    if (IN(10)) GEMM_PHASE_SLAB(EpiResM, WS_ACT, WS_WF_OUT + 6 * MiB, FFN, ws, (const float*)nullptr, (const float*)nullptr); SEAM(10);
    if (IN(11)) final_norm_phase(F, *ARGP());


#undef IN
#undef SEAM
#undef GEMM_PHASE
#undef TAIL_PHASE
#undef GEMM_PHASE_SLAB
#undef GEMM_PHASE_SLAB2
#undef ARGP
}

extern "C" void kernel_launch(void* const* d_in, const int* in_sizes, int n_in, void* d_out, int out_size, void* d_ws, size_t ws_size, hipStream_t stream) {
    static int grid = 0;
    if (grid == 0) {
        if (n_in != 25 || out_size != (int)O_END || ws_size < WS_END) { fprintf(stderr, "kernel_launch: unexpected shapes (n_in %d, out %d, ws %zu); nothing launched\n", n_in, out_size, ws_size); grid = -1; return; }
        int dev = 0, cus = 0, per_cu = 0;
        if (hipGetDevice(&dev) != hipSuccess || hipDeviceGetAttribute(&cus, hipDeviceAttributeMultiprocessorCount, dev) != hipSuccess) { grid = -1; return; }
        if (hipFuncSetAttribute((const void*)mk_fwd, hipFuncAttributeMaxDynamicSharedMemorySize, LDS_BYTES) != hipSuccess) { fprintf(stderr, "kernel_launch: hipFuncSetAttribute failed\n"); grid = -1; return; }
        if (hipOccupancyMaxActiveBlocksPerMultiprocessor(&per_cu, (const void*)mk_fwd, NWAVES * 64, LDS_BYTES) != hipSuccess || per_cu < 1) { fprintf(stderr, "kernel_launch: occupancy query reports %d workgroups per CU\n", per_cu); }
        (void)hipGetLastError();
        grid = cus;
    }
    if (grid < 0) return;
    if (hipMemsetAsync((char*)d_ws + WS_CTL, 0, CTL_ZERO_BYTES, stream) != hipSuccess) return;
    Args a{};
    for (int i = 0; i < 25; ++i) a.in[i] = d_in[i];
    a.out = (float*)d_out; a.ws = (unsigned char*)d_ws;
#if MK_PER_PHASE
    for (int p = 0; p < N_PHASES; ++p) { a.ph_lo = p; a.ph_hi = p + 1; hipLaunchKernelGGL(mk_fwd, dim3(grid), dim3(NWAVES * 64), LDS_BYTES, stream, a); }
#else
    a.ph_lo = 0; a.ph_hi = N_PHASES;
    hipLaunchKernelGGL(mk_fwd, dim3(grid), dim3(NWAVES * 64), LDS_BYTES, stream, a);
#endif
}
```
